# Optimizing an MI355X kernel written in HIP

```python
import jax, jax.numpy as jnp
from jax import lax
import numpy as np

D_MODEL = 1024
BATCH = 4
SEQ = 4096
DEPTH = 2

CHUNK = 64
N_MIXERS = 2
EPS = 1e-6

GMLP_BLOCK = 128
GMLP_D_FFN = 6 * D_MODEL
GMLP_HALF = GMLP_D_FFN // 2
GMLP_GROUPS = 8
GMLP_GROUP_DIM = GMLP_HALF // GMLP_GROUPS

ATT_HEADS = 16
ATT_HEAD_DIM = D_MODEL // ATT_HEADS
ATT_LEFT_CHUNKS = 8
ATT_BAND = (ATT_LEFT_CHUNKS + 1) * CHUNK
REL_CLIP = 256
REL_SIZE = REL_CLIP + CHUNK

FFN_DIM = 2816
N_EXPERTS = 8
TOP_K = 2
EXPERT_DIM = 3584

N_A = (DEPTH + 1) // 2
N_B = DEPTH // 2

kernel_name = "hybrid_gmlp_bandattn_moe_streaming"


def rmsnorm(x, g):
    xf = x.astype(jnp.float32)
    y = xf * lax.rsqrt(jnp.mean(xf * xf, axis=-1, keepdims=True) + EPS)
    return (y * g.astype(jnp.float32)).astype(x.dtype)


def swiglu(h, w_gate, w_up, w_down):
    return (jax.nn.silu(h @ w_gate) * (h @ w_up)) @ w_down


def gmlp_mixer(h, w_in, v_gain, w_s, b_s, w_out):
    B, S, _ = h.shape
    z = jax.nn.gelu(h @ w_in, approximate=False)
    u, v = jnp.split(z, 2, axis=-1)
    v = rmsnorm(v, v_gain)
    nb = S // GMLP_BLOCK
    v = v.reshape(B, nb, GMLP_BLOCK, GMLP_GROUPS, GMLP_GROUP_DIM)
    chunk_id = jnp.arange(GMLP_BLOCK) // CHUNK
    mask = chunk_id[:, None] >= chunk_id[None, :]
    w = jnp.where(mask[None], w_s, jnp.zeros_like(w_s))
    sv = jnp.einsum('gts,bnsgc->bntgc', w, v) + b_s.T[None, None, :, :, None]
    gated = u * sv.reshape(B, S, GMLP_HALF)
    return gated @ w_out


def band_attention(h, w_qkv, rel_table, w_o):
    B, S, _ = h.shape
    nc = S // CHUNK
    qkv = (h @ w_qkv).reshape(B, S, 3, ATT_HEADS, ATT_HEAD_DIM)
    q, k, v = qkv[:, :, 0], qkv[:, :, 1], qkv[:, :, 2]
    pad = ATT_LEFT_CHUNKS * CHUNK
    k_pad = jnp.pad(k, ((0, 0), (pad, 0), (0, 0), (0, 0)))
    v_pad = jnp.pad(v, ((0, 0), (pad, 0), (0, 0), (0, 0)))
    q_chunks = q.reshape(B, nc, CHUNK, ATT_HEADS, ATT_HEAD_DIM).transpose(1, 0, 2, 3, 4)
    qi = jnp.arange(CHUNK)[:, None]
    kj = jnp.arange(ATT_BAND)
    dist = pad + qi - kj[None, :]
    idx = jnp.clip(dist, -(CHUNK - 1), REL_CLIP) + (CHUNK - 1)
    bias = rel_table[:, idx].astype(jnp.float32)
    scale = ATT_HEAD_DIM ** -0.5

    def one_chunk(args):
        n, q_n = args
        k_b = lax.dynamic_slice_in_dim(k_pad, n * CHUNK, ATT_BAND, axis=1)
        v_b = lax.dynamic_slice_in_dim(v_pad, n * CHUNK, ATT_BAND, axis=1)
        s = jnp.einsum('bqhd,bkhd->bhqk', q_n, k_b).astype(jnp.float32) * scale + bias
        valid = (n - ATT_LEFT_CHUNKS) * CHUNK + kj >= 0
        s = jnp.where(valid, s, -1e30)
        p = jax.nn.softmax(s, axis=-1).astype(v_b.dtype)
        return jnp.einsum('bhqk,bkhd->bqhd', p, v_b)

    o = lax.map(one_chunk, (jnp.arange(nc), q_chunks))
    o = o.transpose(1, 0, 2, 3, 4).reshape(B, S, D_MODEL)
    return o @ w_o


def moe_swiglu(h, router_w, router_b, w_gate, w_up, w_down):
    B, S, D = h.shape
    t = h.reshape(-1, D)
    logits = (t @ router_w).astype(jnp.float32) + router_b.astype(jnp.float32)
    top_vals, top_idx = lax.top_k(logits, TOP_K)
    top_w = jax.nn.softmax(top_vals, axis=-1)
    gates = jnp.sum(jax.nn.one_hot(top_idx, N_EXPERTS, dtype=jnp.float32) * top_w[..., None],
                    axis=1).astype(h.dtype)
    y = jnp.zeros_like(t)
    for e in range(N_EXPERTS):
        y = y + gates[:, e:e + 1] * swiglu(t, w_gate[e], w_up[e], w_down[e])
    return y.reshape(B, S, D)


def setup_inputs(seed: int = 0) -> dict:
    key = jax.random.key(seed)
    ks = jax.random.split(key, 24)
    f32 = jnp.float32

    def nrm(k, shape, scale):
        return jax.random.normal(k, shape, f32) * scale

    D = D_MODEL
    return {
        "x": nrm(ks[0], (BATCH, SEQ, D), 1.0),
        "norm_mix_g": 1.0 + nrm(ks[1], (DEPTH, D), 0.02),
        "norm_ffn_g": 1.0 + nrm(ks[2], (DEPTH, D), 0.02),
        "final_g": 1.0 + nrm(ks[3], (D,), 0.02),
        "a_w_in": nrm(ks[4], (N_A, D, GMLP_D_FFN), D ** -0.5),
        "a_v_gain": 1.0 + nrm(ks[5], (N_A, GMLP_HALF), 0.02),
        "a_w_s": nrm(ks[6], (N_A, GMLP_GROUPS, GMLP_BLOCK, GMLP_BLOCK), GMLP_BLOCK ** -0.5),
        "a_b_s": 1.0 + nrm(ks[7], (N_A, GMLP_GROUPS, GMLP_BLOCK), 0.02),
        "a_w_out": nrm(ks[8], (N_A, GMLP_HALF, D), GMLP_HALF ** -0.5),
        "a_ffn_gate": nrm(ks[9], (N_A, D, FFN_DIM), D ** -0.5),
        "a_ffn_up": nrm(ks[10], (N_A, D, FFN_DIM), D ** -0.5),
        "a_ffn_down": nrm(ks[11], (N_A, FFN_DIM, D), FFN_DIM ** -0.5),
        "b_w_qkv": nrm(ks[12], (N_B, D, 3 * D), D ** -0.5),
        "b_rel_bias": nrm(ks[13], (N_B, ATT_HEADS, REL_SIZE), 0.1),
        "b_w_o": nrm(ks[14], (N_B, D, D), D ** -0.5),
        "b_router_w": nrm(ks[15], (N_B, D, N_EXPERTS), D ** -0.5),
        "b_router_b": nrm(ks[16], (N_B, N_EXPERTS), 0.01),
        "b_exp_gate": nrm(ks[17], (N_B, N_EXPERTS, D, EXPERT_DIM), D ** -0.5),
        "b_exp_up": nrm(ks[18], (N_B, N_EXPERTS, D, EXPERT_DIM), D ** -0.5),
        "b_exp_down": nrm(ks[19], (N_B, N_EXPERTS, EXPERT_DIM, D), EXPERT_DIM ** -0.5),
    }


def reference(x, norm_mix_g, norm_ffn_g, final_g,
              a_w_in, a_v_gain, a_w_s, a_b_s, a_w_out,
              a_ffn_gate, a_ffn_up, a_ffn_down,
              b_w_qkv, b_rel_bias, b_w_o,
              b_router_w, b_router_b, b_exp_gate, b_exp_up, b_exp_down):
    for i in range(DEPTH):
        j = i // N_MIXERS
        h = rmsnorm(x, norm_mix_g[i])
        if i % N_MIXERS == 0:
            x = x + gmlp_mixer(h, a_w_in[j], a_v_gain[j], a_w_s[j], a_b_s[j], a_w_out[j])
        else:
            x = x + band_attention(h, b_w_qkv[j], b_rel_bias[j], b_w_o[j])
        h = rmsnorm(x, norm_ffn_g[i])
        if i % 2 == 0:
            x = x + swiglu(h, a_ffn_gate[j], a_ffn_up[j], a_ffn_down[j])
        else:
            x = x + moe_swiglu(h, b_router_w[j], b_router_b[j],
                               b_exp_gate[j], b_exp_up[j], b_exp_down[j])
    return rmsnorm(x, final_g)
```

```cpp
#include <hip/hip_runtime.h>
#include <cstdint>
#include <cstdio>

typedef unsigned short bf16_t;
namespace nv {
constexpr int T = 16384, D = 1024, SEQ = 4096, NB = 4;
constexpr int DFF = 6144, HALF = 3072, GRP = 8, GDIM = 384, GBLK = 128, CHUNK = 64;
constexpr int NH = 16, HD = 64, LEFT = 8, BAND = 576, RELSZ = 320, RELCLIP = 256;
constexpr int FFN = 2816, NE = 8, EDIM = 3584;
constexpr float EPS = 1e-6f;

__device__ __forceinline__ float ldf(const float* p) { return *p; }
__device__ __forceinline__ float ldf(const bf16_t* p) { return __uint_as_float(((unsigned)*p) << 16); }
__device__ __forceinline__ float wave_sum(float v) {
#pragma unroll
    for (int o = 1; o < 64; o <<= 1) v += __shfl_xor(v, o);
    return v;
}
__device__ __forceinline__ float gelu_erf(float v) { return 0.5f * v * (1.0f + erff(v * 0.70710678118654752f)); }
__device__ __forceinline__ float silu(float v) { return v / (1.0f + __expf(-v)); }

__global__ void k_rmsnorm(const float* x, const float* g, float* out) {
    const int row = blockIdx.x * 4 + (threadIdx.x >> 6), lane = threadIdx.x & 63;
    const float* xr = x + (size_t)row * D; float v[16]; float s = 0.f;
#pragma unroll
    for (int j = 0; j < 16; ++j) { v[j] = xr[lane + 64 * j]; s += v[j] * v[j]; }
    const float r = rsqrtf(wave_sum(s) * (1.0f / D) + EPS);
#pragma unroll
    for (int j = 0; j < 16; ++j) out[(size_t)row * D + lane + 64 * j] = v[j] * r * g[lane + 64 * j];
}
template <typename TZ> __global__ void k_vscale(const TZ* Z, float* rs) {
    const int row = blockIdx.x * 4 + (threadIdx.x >> 6), lane = threadIdx.x & 63;
    const TZ* zr = Z + (size_t)row * DFF + HALF; float s = 0.f;
    for (int j = lane; j < HALF; j += 64) { const float v = ldf(zr + j); s += v * v; }
    s = wave_sum(s);
    if (lane == 0) rs[row] = rsqrtf(s * (1.0f / HALF) + EPS);
}
__global__ void k_gate(float* Z, const float* rs, const float* gain, const float* ws, const float* bs) {
    const int c = blockIdx.x * 256 + threadIdx.x, t = blockIdx.y, g = c / GDIM, blk = t / GBLK, tt = t % GBLK;
    const int smax = (tt / CHUNK + 1) * CHUNK; float acc = 0.f;
    const float* w = ws + ((size_t)g * GBLK + tt) * GBLK;
    for (int s = 0; s < smax; ++s) acc += w[s] * rs[blk * GBLK + s] * Z[(size_t)(blk * GBLK + s) * DFF + HALF + c];
    const float sv = acc * gain[c] + bs[g * GBLK + tt];
    Z[(size_t)t * DFF + c] *= sv;
}

struct SG {
    const void* A; const int* rowidx  ; const int* rowoff  ; const int* cnt  ;
    const float* B1; const float* B2; size_t b_zstride; int lda, idx_zstride, M, N, K, ldb;
};
static SG mk(const void* A, int lda, const int* rowidx, int idxz, const int* rowoff, const int* cnt, int M, int N, int K, const float* B1, const float* B2, int ldb, size_t bz) {
    SG p; p.A = A; p.rowidx = rowidx; p.rowoff = rowoff; p.cnt = cnt; p.B1 = B1; p.B2 = B2; p.b_zstride = bz; p.lda = lda; p.idx_zstride = idxz; p.M = M; p.N = N; p.K = K; p.ldb = ldb; return p; }
template <typename TA, bool DUAL, class Epi>
__global__ void __launch_bounds__(256) k_sgemm(SG p, Epi epi) {
    __shared__ float As[16][132]; __shared__ float Bs1[16][128]; __shared__ float Bs2[DUAL ? 16 : 1][128];
    const int z = blockIdx.z, tid = threadIdx.x, m0 = blockIdx.y * 128, n0 = blockIdx.x * 128;
    const int Mz = p.cnt ? p.cnt[z] : p.M;
    if (m0 >= Mz) return;
    const float* B1 = p.B1 + (size_t)z * p.b_zstride; const float* B2 = DUAL ? p.B2 + (size_t)z * p.b_zstride : nullptr;
    const int ar = tid >> 1, ak = (tid & 1) * 8;
    int arow = m0 + ar; if (arow >= Mz) arow = Mz - 1;
    size_t asrc;
    if (p.rowidx) asrc = (size_t)p.rowidx[(size_t)z * p.idx_zstride + arow];
    else asrc = (size_t)(p.rowoff ? p.rowoff[z] : 0) + arow;
    const TA* Ap = (const TA*)p.A + asrc * p.lda + ak;
    const int bk = tid >> 4, bc = (tid & 15) * 8;
    const int ty = tid >> 4, tx = tid & 15;
    float acc1[8][8], acc2[DUAL ? 8 : 1][8];
#pragma unroll
    for (int i = 0; i < 8; ++i)
#pragma unroll
        for (int j = 0; j < 8; ++j) { acc1[i][j] = 0.f; if (DUAL) acc2[i][j] = 0.f; }
    for (int k0 = 0; k0 < p.K; k0 += 16) {
#pragma unroll
        for (int j = 0; j < 8; ++j) As[ak + j][ar] = ldf(Ap + k0 + j);
        {
            const float4* b = (const float4*)(B1 + (size_t)(k0 + bk) * p.ldb + n0 + bc);
            const float4 b0 = b[0], b1 = b[1];
            *(float4*)&Bs1[bk][bc] = b0; *(float4*)&Bs1[bk][bc + 4] = b1;
            if (DUAL) { const float4* c = (const float4*)(B2 + (size_t)(k0 + bk) * p.ldb + n0 + bc); const float4 c0 = c[0], c1 = c[1];
                *(float4*)&Bs2[bk][bc] = c0; *(float4*)&Bs2[bk][bc + 4] = c1; }
        }
        __syncthreads();
#pragma unroll
        for (int k = 0; k < 16; ++k) {
            float a[8], b[8], c[8];
#pragma unroll
            for (int i = 0; i < 8; ++i) a[i] = As[k][ty * 8 + i];
#pragma unroll
            for (int j = 0; j < 8; ++j) { b[j] = Bs1[k][tx * 8 + j]; if (DUAL) c[j] = Bs2[k][tx * 8 + j]; }
#pragma unroll
            for (int i = 0; i < 8; ++i)
#pragma unroll
                for (int j = 0; j < 8; ++j) { acc1[i][j] += a[i] * b[j]; if (DUAL) acc2[i][j] += a[i] * c[j]; }
        }
        __syncthreads();
    }
#pragma unroll
    for (int i = 0; i < 8; ++i) { const int r = m0 + ty * 8 + i; if (r < Mz) {
#pragma unroll
        for (int j = 0; j < 8; ++j) epi(z, r, n0 + tx * 8 + j, acc1[i][j], DUAL ? acc2[i][j] : 0.f); } }
}
struct EpiGelu { float* O; int ldo, pad; __device__ void operator()(int, int r, int c, float a, float) const { O[(size_t)r * ldo + c] = gelu_erf(a); } };
struct EpiStore { float* O; int ldo, pad; __device__ void operator()(int, int r, int c, float a, float) const { O[(size_t)r * ldo + c] = a; } };
struct EpiResid { const float* X; float* O; int ldo, pad; __device__ void operator()(int, int r, int c, float a, float) const { O[(size_t)r * ldo + c] = X[(size_t)r * ldo + c] + a; } };
struct EpiSwiglu { float* O; int ldo, pad; __device__ void operator()(int, int r, int c, float a, float b) const { O[(size_t)r * ldo + c] = silu(a) * b; } };
struct EpiMoe1 { float* H; const int* off; int ldo, pad; __device__ void operator()(int z, int r, int c, float a, float b) const { H[(size_t)(off[z] + r) * ldo + c] = silu(a) * b; } };
struct EpiMoe2 { float* Y; const int* off; int accum, pad; __device__ void operator()(int z, int r, int c, float a, float) const { float* y = Y + (size_t)(off[z] + r) * D + c; *y = accum ? *y + a : a; } };

template <typename TQ> __global__ void __launch_bounds__(64) k_attn(const TQ* QKV, const float* rel, float* O) {
    __shared__ float Ks[64][65], Vs[64][65];
    const int n = blockIdx.x, h = blockIdx.y, b = blockIdx.z, i = threadIdx.x;
    const size_t rowq = (size_t)b * SEQ + n * CHUNK + i;
    float q[64], o[64];
#pragma unroll
    for (int d = 0; d < 64; ++d) { q[d] = ldf(QKV + rowq * (3 * D) + h * HD + d); o[d] = 0.f; }
    float m = -1e30f, l = 0.f;
    const float* rb = rel + h * RELSZ;
    for (int c = n - LEFT; c <= n; ++c) {
        if (c < 0) continue;
        __syncthreads();
        for (int e = i; e < 64 * 64; e += 64) { const int kr = e >> 6, d = e & 63; const size_t row = (size_t)b * SEQ + c * CHUNK + kr;
            Ks[kr][d] = ldf(QKV + row * (3 * D) + D + h * HD + d); Vs[kr][d] = ldf(QKV + row * (3 * D) + 2 * D + h * HD + d); }
        __syncthreads();
        for (int j = 0; j < 64; ++j) {
            float s = 0.f;
#pragma unroll
            for (int d = 0; d < 64; ++d) s += q[d] * Ks[j][d];
            int dist = (n * CHUNK + i) - (c * CHUNK + j); dist = dist < -(CHUNK - 1) ? -(CHUNK - 1) : (dist > RELCLIP ? RELCLIP : dist);
            s = s * 0.125f + rb[dist + CHUNK - 1];
            const float mn = fmaxf(m, s), corr = __expf(m - mn), pj = __expf(s - mn);
            l = l * corr + pj; m = mn;
#pragma unroll
            for (int d = 0; d < 64; ++d) o[d] = o[d] * corr + pj * Vs[j][d];
        }
    }
    const float inv = 1.0f / l;
#pragma unroll
    for (int d = 0; d < 64; ++d) O[rowq * D + h * HD + d] = o[d] * inv;
}

__global__ void k_router(const float* hn, const float* rw, const float* rbias, int* cnt, int* list, int* tokslot, float* tokw) {
    const int t = blockIdx.x * 4 + (threadIdx.x >> 6), lane = threadIdx.x & 63;
    float lg[NE];
#pragma unroll
    for (int e = 0; e < NE; ++e) lg[e] = 0.f;
    for (int k = lane; k < D; k += 64) { const float hv = hn[(size_t)t * D + k];
#pragma unroll
        for (int e = 0; e < NE; ++e) lg[e] += hv * rw[k * NE + e]; }
#pragma unroll
    for (int e = 0; e < NE; ++e) lg[e] = wave_sum(lg[e]) + rbias[e];
    if (lane == 0) {
        int e1 = 0; for (int e = 1; e < NE; ++e) if (lg[e] > lg[e1]) e1 = e;
        int e2 = -1; for (int e = 0; e < NE; ++e) if (e != e1 && (e2 < 0 || lg[e] > lg[e2])) e2 = e;
        const float w2 = 1.0f / (1.0f + __expf(lg[e1] - lg[e2])), w1 = 1.0f - w2;
        const int p1 = atomicAdd(&cnt[e1], 1), p2 = atomicAdd(&cnt[e2], 1);
        list[e1 * T + p1] = t; list[e2 * T + p2] = t;
        tokslot[t * 4 + 0] = e1; tokslot[t * 4 + 1] = p1; tokslot[t * 4 + 2] = e2; tokslot[t * 4 + 3] = p2;
        tokw[t * 2 + 0] = w1; tokw[t * 2 + 1] = w2;
    }
}
__global__ void k_offsets(const int* cnt, int* off) { if (threadIdx.x == 0) { int o = 0; for (int e = 0; e < NE; ++e) { off[e] = o; o += (cnt[e] + 255) / 256 * 256; } } }
__global__ void k_combine_final(float* x, const float* Y, const int* off, const int* tokslot, const float* tokw, const float* g) {
    const int t = blockIdx.x * 4 + (threadIdx.x >> 6), lane = threadIdx.x & 63;
    const size_t s1 = (size_t)off[tokslot[t * 4 + 0]] + tokslot[t * 4 + 1], s2 = (size_t)off[tokslot[t * 4 + 2]] + tokslot[t * 4 + 3];
    const float w1 = tokw[t * 2], w2 = tokw[t * 2 + 1];
    float v[16]; float s = 0.f;
#pragma unroll
    for (int j = 0; j < 16; ++j) { const int c = lane + 64 * j; v[j] = x[(size_t)t * D + c] + w1 * Y[s1 * D + c] + w2 * Y[s2 * D + c]; s += v[j] * v[j]; }
    const float r = rsqrtf(wave_sum(s) * (1.0f / D) + EPS);
#pragma unroll
    for (int j = 0; j < 16; ++j) { const int c = lane + 64 * j; x[(size_t)t * D + c] = v[j] * r * g[c]; }
}
}

extern "C" void kernel_launch(void* const* d_in, const int* in_sizes, int n_in, void* d_out, int out_size, void* d_ws, size_t ws_size, hipStream_t stream) {
    using namespace nv;
    const float* x = (const float*)d_in[0]; const float* norm_mix_g = (const float*)d_in[1]; const float* norm_ffn_g = (const float*)d_in[2]; const float* final_g = (const float*)d_in[3];
    const float* a_w_in = (const float*)d_in[4]; const float* a_v_gain = (const float*)d_in[5]; const float* a_w_s = (const float*)d_in[6]; const float* a_b_s = (const float*)d_in[7];
    const float* a_w_out = (const float*)d_in[8]; const float* a_ffn_gate = (const float*)d_in[9]; const float* a_ffn_up = (const float*)d_in[10]; const float* a_ffn_down = (const float*)d_in[11];
    const float* b_w_qkv = (const float*)d_in[12]; const float* b_rel = (const float*)d_in[13]; const float* b_w_o = (const float*)d_in[14];
    const float* b_router_w = (const float*)d_in[15]; const float* b_router_b = (const float*)d_in[16];
    const float* b_exp_gate = (const float*)d_in[17]; const float* b_exp_up = (const float*)d_in[18]; const float* b_exp_down = (const float*)d_in[19];
    float* out = (float*)d_out; unsigned char* ws = (unsigned char*)d_ws;
    constexpr size_t MiB = 1u << 20;
    if (n_in != 20 || out_size != T * D || ws_size < 453 * MiB) { fprintf(stderr, "kernel_launch: unexpected sizes\n"); return; }
    int* cnt = (int*)ws; int* off = cnt + 64;
    int* list = (int*)(ws + 1 * MiB); int* tokslot = (int*)(ws + 2 * MiB); float* tokw = (float*)(ws + 3 * MiB - 256 * 1024); float* rs = (float*)(ws + 3 * MiB);
    float* Hn = (float*)(ws + 4 * MiB); float* R2 = (float*)(ws + 68 * MiB);
    hipMemsetAsync(ws, 0, 4096, stream);
    k_rmsnorm<<<T / 4, 256, 0, stream>>>(x, norm_mix_g, Hn);
    float* Z = R2;
    { SG p = mk(Hn, D, nullptr, 0, nullptr, nullptr, T, DFF, D, a_w_in, nullptr, DFF, 0); k_sgemm<float, false, EpiGelu><<<dim3(DFF / 128, T / 128, 1), 256, 0, stream>>>(p, EpiGelu{Z, DFF, 0}); }
    k_vscale<float><<<T / 4, 256, 0, stream>>>(Z, rs);
    k_gate<<<dim3(HALF / 256, T), 256, 0, stream>>>(Z, rs, a_v_gain, a_w_s, a_b_s);
    { SG p = mk(Z, DFF, nullptr, 0, nullptr, nullptr, T, D, HALF, a_w_out, nullptr, D, 0); k_sgemm<float, false, EpiResid><<<dim3(D / 128, T / 128, 1), 256, 0, stream>>>(p, EpiResid{x, out, D, 0}); }
    k_rmsnorm<<<T / 4, 256, 0, stream>>>(out, norm_ffn_g, Hn);
    float* Hf = R2;
    { SG p = mk(Hn, D, nullptr, 0, nullptr, nullptr, T, FFN, D, a_ffn_gate, a_ffn_up, FFN, 0); k_sgemm<float, true, EpiSwiglu><<<dim3(FFN / 128, T / 128, 1), 256, 0, stream>>>(p, EpiSwiglu{Hf, FFN, 0}); }
    { SG p = mk(Hf, FFN, nullptr, 0, nullptr, nullptr, T, D, FFN, a_ffn_down, nullptr, D, 0); k_sgemm<float, false, EpiResid><<<dim3(D / 128, T / 128, 1), 256, 0, stream>>>(p, EpiResid{out, out, D, 0}); }
    k_rmsnorm<<<T / 4, 256, 0, stream>>>(out, norm_mix_g + D, Hn);
    float* QKV = R2; float* O = R2 + (size_t)T * 3 * D;
    { SG p = mk(Hn, D, nullptr, 0, nullptr, nullptr, T, 3 * D, D, b_w_qkv, nullptr, 3 * D, 0); k_sgemm<float, false, EpiStore><<<dim3(3 * D / 128, T / 128, 1), 256, 0, stream>>>(p, EpiStore{QKV, 3 * D, 0}); }
    k_attn<float><<<dim3(SEQ / CHUNK, NH, NB), 64, 0, stream>>>(QKV, b_rel, O);
    { SG p = mk(O, D, nullptr, 0, nullptr, nullptr, T, D, D, b_w_o, nullptr, D, 0); k_sgemm<float, false, EpiResid><<<dim3(D / 128, T / 128, 1), 256, 0, stream>>>(p, EpiResid{out, out, D, 0}); }
    k_rmsnorm<<<T / 4, 256, 0, stream>>>(out, norm_ffn_g + D, Hn);
    k_router<<<T / 4, 256, 0, stream>>>(Hn, b_router_w, b_router_b, cnt, list, tokslot, tokw);
    k_offsets<<<1, 64, 0, stream>>>(cnt, off);
    float* Hm = R2; float* Y = R2 + (size_t)34816 * 1792;
    for (int half = 0; half < 2; ++half) {
        { SG p = mk(Hn, D, list, T, nullptr, cnt, T, 1792, D, b_exp_gate + half * 1792, b_exp_up + half * 1792, EDIM, (size_t)D * EDIM);
          k_sgemm<float, true, EpiMoe1><<<dim3(1792 / 128, T / 128, NE), 256, 0, stream>>>(p, EpiMoe1{Hm, off, 1792, 0}); }
        { SG p = mk(Hm, 1792, nullptr, 0, off, cnt, T, D, 1792, b_exp_down + (size_t)half * 1792 * D, nullptr, D, (size_t)EDIM * D);
          k_sgemm<float, false, EpiMoe2><<<dim3(D / 128, T / 128, NE), 256, 0, stream>>>(p, EpiMoe2{Y, off, half, 0}); }
    }
    k_combine_final<<<T / 4, 256, 0, stream>>>(out, Y, off, tokslot, tokw, final_g);
}
```

```cpp
#include <hip/hip_runtime.h>
#include <cstdint>
#include <cstdio>

typedef unsigned short bf16_t;
namespace nv {
constexpr int T = 16384, D = 1024, SEQ = 4096, NB = 4;
constexpr int DFF = 6144, HALF = 3072, GRP = 8, GDIM = 384, GBLK = 128, CHUNK = 64;
constexpr int NH = 16, HD = 64, LEFT = 8, BAND = 576, RELSZ = 320, RELCLIP = 256;
constexpr int FFN = 2816, NE = 8, EDIM = 3584;
constexpr float EPS = 1e-6f;

__device__ __forceinline__ float ldf(const float* p) { return *p; }
__device__ __forceinline__ float ldf(const bf16_t* p) { return __uint_as_float(((unsigned)*p) << 16); }
__device__ __forceinline__ void stf(float* p, float v) { *p = v; }
__device__ __forceinline__ void stf(bf16_t* p, float v) { unsigned u = __float_as_uint(v); *p = (bf16_t)((u + 0x7fffu + ((u >> 16) & 1u)) >> 16); }
__device__ __forceinline__ float wave_sum(float v) {
#pragma unroll
    for (int o = 1; o < 64; o <<= 1) v += __shfl_xor(v, o);
    return v;
}
__device__ __forceinline__ float gelu_erf(float v) { return 0.5f * v * (1.0f + erff(v * 0.70710678118654752f)); }
__device__ __forceinline__ float silu(float v) { return v / (1.0f + __expf(-v)); }

__global__ void k_rmsnorm(const float* x, const float* g, float* out) {
    const int row = blockIdx.x * 4 + (threadIdx.x >> 6), lane = threadIdx.x & 63;
    const float* xr = x + (size_t)row * D; float v[16]; float s = 0.f;
#pragma unroll
    for (int j = 0; j < 16; ++j) { v[j] = xr[lane + 64 * j]; s += v[j] * v[j]; }
    const float r = rsqrtf(wave_sum(s) * (1.0f / D) + EPS);
#pragma unroll
    for (int j = 0; j < 16; ++j) out[(size_t)row * D + lane + 64 * j] = v[j] * r * g[lane + 64 * j];
}
template <typename TZ> __global__ void k_vscale(const TZ* Z, float* rs) {
    const int row = blockIdx.x * 4 + (threadIdx.x >> 6), lane = threadIdx.x & 63;
    const TZ* zr = Z + (size_t)row * DFF + HALF; float s = 0.f;
    for (int j = lane; j < HALF; j += 64) { const float v = ldf(zr + j); s += v * v; }
    s = wave_sum(s);
    if (lane == 0) rs[row] = rsqrtf(s * (1.0f / HALF) + EPS);
}
__global__ void k_rs_from_ss(const unsigned long long* ss, float* rs, float inv_n) { const int i = blockIdx.x * 256 + threadIdx.x; rs[i] = rsqrtf((float)ss[i] * (inv_n / 16777216.0f) + EPS); }
template <typename TZ> __global__ void k_gate(TZ* Z, const float* rs, const float* gain, const float* ws, const float* bs) {
    const int c = blockIdx.x * 256 + threadIdx.x, t = blockIdx.y, g = c / GDIM, blk = t / GBLK, tt = t % GBLK;
    const int smax = (tt / CHUNK + 1) * CHUNK; float acc = 0.f;
    const float* w = ws + ((size_t)g * GBLK + tt) * GBLK;
    for (int s = 0; s < smax; ++s) acc += w[s] * rs[blk * GBLK + s] * ldf(Z + (size_t)(blk * GBLK + s) * DFF + HALF + c);
    const float sv = acc * gain[c] + bs[g * GBLK + tt];
    stf(Z + (size_t)t * DFF + c, ldf(Z + (size_t)t * DFF + c) * sv);
}

struct SG {
    const void* A; const int* rowidx  ; const int* rowoff  ; const int* cnt  ;
    const float* B1; const float* B2; size_t b_zstride; int lda, idx_zstride, M, N, K, ldb;
};
static SG mk(const void* A, int lda, const int* rowidx, int idxz, const int* rowoff, const int* cnt, int M, int N, int K, const float* B1, const float* B2, int ldb, size_t bz) {
    SG p; p.A = A; p.rowidx = rowidx; p.rowoff = rowoff; p.cnt = cnt; p.B1 = B1; p.B2 = B2; p.b_zstride = bz; p.lda = lda; p.idx_zstride = idxz; p.M = M; p.N = N; p.K = K; p.ldb = ldb; return p; }
template <typename TA, bool DUAL, class Epi>
__global__ void __launch_bounds__(256) k_sgemm(SG p, Epi epi) {
    __shared__ float As[16][132]; __shared__ float Bs1[16][128]; __shared__ float Bs2[DUAL ? 16 : 1][128];
    const int z = blockIdx.z, tid = threadIdx.x, m0 = blockIdx.y * 128, n0 = blockIdx.x * 128;
    const int Mz = p.cnt ? p.cnt[z] : p.M;
    if (m0 >= Mz) return;
    const float* B1 = p.B1 + (size_t)z * p.b_zstride; const float* B2 = DUAL ? p.B2 + (size_t)z * p.b_zstride : nullptr;
    const int ar = tid >> 1, ak = (tid & 1) * 8;
    int arow = m0 + ar; if (arow >= Mz) arow = Mz - 1;
    size_t asrc;
    if (p.rowidx) asrc = (size_t)p.rowidx[(size_t)z * p.idx_zstride + arow];
    else asrc = (size_t)(p.rowoff ? p.rowoff[z] : 0) + arow;
    const TA* Ap = (const TA*)p.A + asrc * p.lda + ak;
    const int bk = tid >> 4, bc = (tid & 15) * 8;
    const int ty = tid >> 4, tx = tid & 15;
    float acc1[8][8], acc2[DUAL ? 8 : 1][8];
#pragma unroll
    for (int i = 0; i < 8; ++i)
#pragma unroll
        for (int j = 0; j < 8; ++j) { acc1[i][j] = 0.f; if (DUAL) acc2[i][j] = 0.f; }
    for (int k0 = 0; k0 < p.K; k0 += 16) {
#pragma unroll
        for (int j = 0; j < 8; ++j) As[ak + j][ar] = ldf(Ap + k0 + j);
        {
            const float4* b = (const float4*)(B1 + (size_t)(k0 + bk) * p.ldb + n0 + bc);
            const float4 b0 = b[0], b1 = b[1];
            *(float4*)&Bs1[bk][bc] = b0; *(float4*)&Bs1[bk][bc + 4] = b1;
            if (DUAL) { const float4* c = (const float4*)(B2 + (size_t)(k0 + bk) * p.ldb + n0 + bc); const float4 c0 = c[0], c1 = c[1];
                *(float4*)&Bs2[bk][bc] = c0; *(float4*)&Bs2[bk][bc + 4] = c1; }
        }
        __syncthreads();
#pragma unroll
        for (int k = 0; k < 16; ++k) {
            float a[8], b[8], c[8];
#pragma unroll
            for (int i = 0; i < 8; ++i) a[i] = As[k][ty * 8 + i];
#pragma unroll
            for (int j = 0; j < 8; ++j) { b[j] = Bs1[k][tx * 8 + j]; if (DUAL) c[j] = Bs2[k][tx * 8 + j]; }
#pragma unroll
            for (int i = 0; i < 8; ++i)
#pragma unroll
                for (int j = 0; j < 8; ++j) { acc1[i][j] += a[i] * b[j]; if (DUAL) acc2[i][j] += a[i] * c[j]; }
        }
        __syncthreads();
    }
#pragma unroll
    for (int i = 0; i < 8; ++i) { const int r = m0 + ty * 8 + i; if (r < Mz) {
#pragma unroll
        for (int j = 0; j < 8; ++j) epi(z, r, n0 + tx * 8 + j, acc1[i][j], DUAL ? acc2[i][j] : 0.f); } }
}
struct EpiGelu { float* O; int ldo, pad; __device__ void operator()(int, int r, int c, float a, float) const { O[(size_t)r * ldo + c] = gelu_erf(a); } };
struct EpiStore { float* O; int ldo, pad; __device__ void operator()(int, int r, int c, float a, float) const { O[(size_t)r * ldo + c] = a; } };
struct EpiResid { const float* X; float* O; int ldo, pad; __device__ void operator()(int, int r, int c, float a, float) const { O[(size_t)r * ldo + c] = X[(size_t)r * ldo + c] + a; } };
struct EpiSwiglu { float* O; int ldo, pad; __device__ void operator()(int, int r, int c, float a, float b) const { O[(size_t)r * ldo + c] = silu(a) * b; } };
struct EpiMoe1 { float* H; const int* off; int ldo, pad; __device__ void operator()(int z, int r, int c, float a, float b) const { H[(size_t)(off[z] + r) * ldo + c] = silu(a) * b; } };
struct EpiMoe2 { float* Y; const int* off; int accum, pad; __device__ void operator()(int z, int r, int c, float a, float) const { float* y = Y + (size_t)(off[z] + r) * D + c; *y = accum ? *y + a : a; } };

template <typename TQ> __global__ void __launch_bounds__(64) k_attn(const TQ* Qp, const TQ* Kp, const TQ* Vp, int ld, const float* rel, TQ* O) {
    __shared__ float Ks[64][65], Vs[64][65];
    const int n = blockIdx.x, h = blockIdx.y, b = blockIdx.z, i = threadIdx.x;
    const size_t rowq = (size_t)b * SEQ + n * CHUNK + i;
    float q[64], o[64];
#pragma unroll
    for (int d = 0; d < 64; ++d) { q[d] = ldf(Qp + rowq * ld + h * HD + d); o[d] = 0.f; }
    float m = -1e30f, l = 0.f;
    const float* rb = rel + h * RELSZ;
    for (int c = n - LEFT; c <= n; ++c) {
        if (c < 0) continue;
        __syncthreads();
        for (int e = i; e < 64 * 64; e += 64) { const int kr = e >> 6, d = e & 63; const size_t row = (size_t)b * SEQ + c * CHUNK + kr;
            Ks[kr][d] = ldf(Kp + row * ld + h * HD + d); Vs[kr][d] = ldf(Vp + row * ld + h * HD + d); }
        __syncthreads();
        for (int j = 0; j < 64; ++j) {
            float s = 0.f;
#pragma unroll
            for (int d = 0; d < 64; ++d) s += q[d] * Ks[j][d];
            int dist = (n * CHUNK + i) - (c * CHUNK + j); dist = dist < -(CHUNK - 1) ? -(CHUNK - 1) : (dist > RELCLIP ? RELCLIP : dist);
            s = s * 0.125f + rb[dist + CHUNK - 1];
            const float mn = fmaxf(m, s), corr = __expf(m - mn), pj = __expf(s - mn);
            l = l * corr + pj; m = mn;
#pragma unroll
            for (int d = 0; d < 64; ++d) o[d] = o[d] * corr + pj * Vs[j][d];
        }
    }
    const float inv = 1.0f / l;
#pragma unroll
    for (int d = 0; d < 64; ++d) stf(O + rowq * D + h * HD + d, o[d] * inv);
}

__global__ void k_router(const float* hn, const float* rw, const float* rbias, int* cnt, int* list, int* tokslot, float* tokw) {
    const int t = blockIdx.x * 4 + (threadIdx.x >> 6), lane = threadIdx.x & 63;
    float lg[NE];
#pragma unroll
    for (int e = 0; e < NE; ++e) lg[e] = 0.f;
    for (int k = lane; k < D; k += 64) { const float hv = hn[(size_t)t * D + k];
#pragma unroll
        for (int e = 0; e < NE; ++e) lg[e] += hv * rw[k * NE + e]; }
#pragma unroll
    for (int e = 0; e < NE; ++e) lg[e] = wave_sum(lg[e]) + rbias[e];
    if (lane == 0) {
        int e1 = 0; for (int e = 1; e < NE; ++e) if (lg[e] > lg[e1]) e1 = e;
        int e2 = -1; for (int e = 0; e < NE; ++e) if (e != e1 && (e2 < 0 || lg[e] > lg[e2])) e2 = e;
        const float w2 = 1.0f / (1.0f + __expf(lg[e1] - lg[e2])), w1 = 1.0f - w2;
        const int p1 = atomicAdd(&cnt[e1], 1), p2 = atomicAdd(&cnt[e2], 1);
        list[e1 * T + p1] = t; list[e2 * T + p2] = t;
        tokslot[t * 4 + 0] = e1; tokslot[t * 4 + 1] = p1; tokslot[t * 4 + 2] = e2; tokslot[t * 4 + 3] = p2;
        tokw[t * 2 + 0] = w1; tokw[t * 2 + 1] = w2;
    }
}
__global__ void k_offsets(const int* cnt, int* off) { if (threadIdx.x == 0) { int o = 0; for (int e = 0; e < NE; ++e) { off[e] = o; o += (cnt[e] + 255) / 256 * 256; } } }
__global__ void k_combine_final(float* x, const float* Y, const int* off, const int* tokslot, const float* tokw, const float* g) {
    const int t = blockIdx.x * 4 + (threadIdx.x >> 6), lane = threadIdx.x & 63;
    const size_t s1 = (size_t)off[tokslot[t * 4 + 0]] + tokslot[t * 4 + 1], s2 = (size_t)off[tokslot[t * 4 + 2]] + tokslot[t * 4 + 3];
    const float w1 = tokw[t * 2], w2 = tokw[t * 2 + 1];
    float v[16]; float s = 0.f;
#pragma unroll
    for (int j = 0; j < 16; ++j) { const int c = lane + 64 * j; v[j] = x[(size_t)t * D + c] + w1 * Y[s1 * D + c] + w2 * Y[s2 * D + c]; s += v[j] * v[j]; }
    const float r = rsqrtf(wave_sum(s) * (1.0f / D) + EPS);
#pragma unroll
    for (int j = 0; j < 16; ++j) { const int c = lane + 64 * j; x[(size_t)t * D + c] = v[j] * r * g[c]; }
}
}
namespace mk {
#define LAS __attribute__((address_space(3)))
#define GAS __attribute__((address_space(1)))
typedef short bf16x8 __attribute__((ext_vector_type(8)));
typedef short s16x4 __attribute__((ext_vector_type(4)));
typedef float f32x4 __attribute__((ext_vector_type(4)));
typedef float f32x2 __attribute__((ext_vector_type(2)));
typedef unsigned u32x4 __attribute__((ext_vector_type(4)));
typedef unsigned u32x2 __attribute__((ext_vector_type(2)));
typedef GAS unsigned gu32;

constexpr int T = 16384, D = 1024, SEQ = 4096, NB = 4;
constexpr int DFF = 6144, HALFC = 3072, GRP = 8, GDIM = 384, GBLK = 128, CHUNK = 64;
constexpr int NH = 16, HD = 64, LEFT = 8, RELSZ = 320, RELCLIP = 256;
constexpr int FFN = 2816, NE = 8, EDIM = 3584;
constexpr int SLOTS = 34816;
constexpr float EPS = 1e-6f;
constexpr float LOG2E = 1.4426950408889634f;

constexpr size_t KiB = 1024, MiB = 1u << 20;
constexpr size_t WS_CTL = 0, CTL_ZERO_BYTES = 1 * MiB;
constexpr size_t WS_SS0 = 128 * KiB, WS_SSV = 256 * KiB, WS_SS1 = 384 * KiB, WS_SS2 = 512 * KiB;
constexpr size_t WS_LIST = 1 * MiB, WS_TOKSLOT = WS_LIST + 512 * KiB, WS_TOKW = WS_TOKSLOT + 256 * KiB, WS_R3 = 2 * MiB, WS_SLOTW = WS_R3 + 256 * KiB;
constexpr size_t WS_WEGU = 4 * MiB, WS_WED = 116 * MiB;
constexpr size_t WS_WIN = 172 * MiB, WS_WOUT = 184 * MiB, WS_WGU = 190 * MiB, WS_WD = 201 * MiB, WS_WQKV = 207 * MiB, WS_WO = 213 * MiB;
constexpr size_t WS_XB = 215 * MiB;
constexpr size_t WS_Z = 247 * MiB;
constexpr size_t WS_H = 247 * MiB;
constexpr size_t WS_Q = 247 * MiB, WS_K = 279 * MiB, WS_V = 311 * MiB, WS_O = 343 * MiB;
constexpr size_t WS_XG = 172 * MiB;
constexpr size_t WS_HM = 240 * MiB;
constexpr size_t WS_Y = 4 * MiB;
constexpr size_t WS_END = 478 * MiB;
static_assert(WS_HM + (size_t)SLOTS * EDIM * 2 <= WS_END && WS_XG + (size_t)SLOTS * D * 2 <= WS_HM && WS_Z + (size_t)T * DFF * 2 <= WS_END && WS_WO + 2 * MiB <= WS_XB, "ws map");
constexpr int CW_TMO = 0, CW_CNT = 64, CW_BAR = 4096;

constexpr int RING_BYTES = 131072, LDSCTL_OFF = 143360, MISC_OFF = LDSCTL_OFF + 320, LDS_BYTES = 147456;
constexpr int NWAVES = 8;

#define RLX_AGENT __ATOMIC_RELAXED, __HIP_MEMORY_SCOPE_AGENT
typedef unsigned long long u64;
constexpr float SS_SCALE = 16777216.0f, SS_INV = 1.0f / 16777216.0f;
__device__ __forceinline__ float rs_of(const u64* ss, int row, float inv_n) { return rsqrtf((float)ss[row] * (SS_INV * inv_n) + 1e-6f); }
__device__ __forceinline__ void ss_add(u64* ss, int row, float q) { __hip_atomic_fetch_add(ss + row, (u64)(q * SS_SCALE), RLX_AGENT); }
#define LDS_WAIT() asm volatile("s_waitcnt lgkmcnt(0)" ::: "memory")
#define VM_WAIT() asm volatile("s_waitcnt vmcnt(0)" ::: "memory")
__device__ __forceinline__ unsigned cvt_pk_bf16(float lo, float hi) { unsigned r; asm volatile("v_cvt_pk_bf16_f32 %0, %1, %2" : "=v"(r) : "v"(lo), "v"(hi)); return r; }
__device__ __forceinline__ float bf2f(unsigned short b) { return __uint_as_float(((unsigned)b) << 16); }
__device__ __forceinline__ float wave_sum(float v) {
#pragma unroll
    for (int o = 1; o < 64; o <<= 1) v += __shfl_xor(v, o);
    return v;
}

#define XB_TMO      128
#define XB_XCNT(j)  (256  + 64 * (j))
#define XB_XSUB(j)  (1280 + 64 * (j))
#define XB_XGEN(j)  (2304 + 64 * (j))
#define XB_TOP      3328
#define XB_TOPGEN   3392
#define XCD_BAR_WORDS 3456
#define XB_SPIN_CAP (1u << 18)
__device__ __forceinline__ unsigned xb_ld(unsigned* p)              { return __hip_atomic_load(p, __ATOMIC_RELAXED, __HIP_MEMORY_SCOPE_AGENT); }
__device__ __forceinline__ unsigned xb_add(unsigned* p, unsigned v) { return __hip_atomic_fetch_add(p, v, __ATOMIC_RELAXED, __HIP_MEMORY_SCOPE_AGENT); }
__device__ __forceinline__ unsigned xb_xcc_id() { return (unsigned)__builtin_amdgcn_s_getreg((3 << 11) | 20) & 0xFu; }
#define XB_SPIN(cond, bar) do { unsigned _sp = 0; while (cond) { __builtin_amdgcn_s_sleep(1); \
    if ((++_sp & 255u) == 0u) { if (xb_ld(&(bar)[XB_TMO])) break; if (_sp > XB_SPIN_CAP) { atomicAdd(&(bar)[XB_TMO], 1u); break; } } } } while (0)
struct XcdBarrier { unsigned* bar; unsigned x; volatile LAS unsigned* st; };
__device__ __forceinline__ XcdBarrier xcd_barrier_post(unsigned* bar, volatile LAS unsigned* st) {
    XcdBarrier b; b.bar = bar; b.x = xb_xcc_id(); b.st = st;
    if (threadIdx.x == 0) (void)xb_add(&bar[XB_XCNT(b.x)], 1u);
    return b;
}
__device__ __forceinline__ void xcd_barrier_complete(unsigned* bar, unsigned x, unsigned& nloc, unsigned& nx) {
    const unsigned G = gridDim.x * gridDim.y * gridDim.z;
    unsigned sum, cnt, mine, sp = 0u;
    for (;;) {
        sum = 0u; cnt = 0u; mine = 0u;
#pragma unroll
        for (unsigned j = 0; j < 16; ++j) { const unsigned c = xb_ld(&bar[XB_XCNT(j)]); sum += c; cnt += (c > 0u) ? 1u : 0u; mine = (j == x) ? c : mine; }
        if (sum == G) break;
        __builtin_amdgcn_s_sleep(1);
        if ((++sp & 255u) == 0u) { if (xb_ld(&bar[XB_TMO])) break; if (sp > XB_SPIN_CAP) { atomicAdd(&bar[XB_TMO], 1u); break; } }
    }
    nloc = mine > 0u ? mine : 1u; nx = cnt > 0u ? cnt : 1u;
}
__device__ __forceinline__ void xcd_barrier(const XcdBarrier& b) {
    asm volatile("s_waitcnt vmcnt(0)" ::: "memory");
    __syncthreads();
    if (threadIdx.x == 0) {
        unsigned* bar = b.bar;
        __builtin_amdgcn_s_waitcnt(0);
        unsigned nloc = b.st[0], nx = b.st[1];
        if (nloc == 0u) { xcd_barrier_complete(bar, b.x, nloc, nx); b.st[0] = nloc; b.st[1] = nx; }
        const unsigned old = xb_add(&bar[XB_XSUB(b.x)], 1u);
        const unsigned gen = old / nloc;
        if (old + 1u == (gen + 1u) * nloc) {
            __builtin_amdgcn_fence(__ATOMIC_RELEASE, "agent");
            asm volatile("s_waitcnt vmcnt(0)" ::: "memory");
            const unsigned og = xb_add(&bar[XB_TOP], 1u);
            const unsigned tg = og / nx;
            if (og + 1u == (tg + 1u) * nx) xb_add(&bar[XB_TOPGEN], 1u);
            else XB_SPIN(xb_ld(&bar[XB_TOPGEN]) == tg, bar);
            __builtin_amdgcn_fence(__ATOMIC_ACQUIRE, "agent");
            xb_add(&bar[XB_XGEN(b.x)], 1u);
            asm volatile("s_waitcnt vmcnt(0)" ::: "memory");
        } else {
            XB_SPIN(xb_ld(&bar[XB_XGEN(b.x)]) == gen, bar);
            __builtin_amdgcn_fence(__ATOMIC_ACQUIRE, "agent");
            asm volatile("s_waitcnt vmcnt(0)" ::: "memory");
        }
    }
    __syncthreads();
}

constexpr int BM = 256, BK = 64, HALF = 128, HTB = HALF * BK * 2, NXCD = 8, WGM = 8;
__device__ __forceinline__ int lds_byte(int r, int c) { const int st = (r >> 4) * 2 + (c >> 5), rr = r & 15, cc = c & 31, ob = rr * 64 + cc * 2; return st * 1024 + (ob ^ (((ob >> 9) & 1) << 5)); }
__device__ __forceinline__ void stage_rc(int b, int& R, int& C) { const int st = b / 1024, sb = b % 1024, swz = sb ^ (((sb >> 9) & 1) << 5); R = (st >> 1) * 16 + swz / 64; C = (st & 1) * 32 + (swz % 64) / 2; }
__device__ __forceinline__ int perm32(int rho) { const int n = rho >> 4, i = rho & 15; return 8 * (i >> 2) + 4 * n + (i & 3); }

struct Unit { int pm, pn, e, rows; int arow, brow; };

__device__ __forceinline__ void tile_of(int L, int nM, int nN, int& pm, int& pn) {
    const int nwg = nM * nN; int wgid = L;
    { const int q = nwg / NXCD, r = nwg % NXCD, xcd = wgid % NXCD, off = wgid / NXCD; wgid = (xcd < r ? xcd * (q + 1) : r * (q + 1) + (xcd - r) * q) + off; }
    const int nig = WGM * nN, gid = wgid / nig, fm = gid * WGM, gsz = (nM - fm) < WGM ? (nM - fm) : WGM;
    pm = fm + ((wgid % nig) % gsz); pn = (wgid % nig) / gsz;
}
struct DenseOrder {
    int nM, nN, G, c;
    __device__ __forceinline__ bool next(int i, Unit& u) const {
        const long L = (long)i * G + c; if (L >= (long)nM * nN) return false;
        tile_of((int)L, nM, nN, u.pm, u.pn); u.e = 0; u.rows = BM; u.arow = u.pm * BM; u.brow = u.pn * BM; return true;
    }
};
struct MoeOrder {
    int t1, t2, t3, t4, t5, t6, t7, nM, nN, G, c, bexp; int c0, c1, c2, c3, c4, c5, c6, c7;
    __device__ __forceinline__ void init(const int* cnt, int nN_, int G_, int c_, int bexp_) {
        c0 = cnt[0]; c1 = cnt[1]; c2 = cnt[2]; c3 = cnt[3]; c4 = cnt[4]; c5 = cnt[5]; c6 = cnt[6]; c7 = cnt[7];
        t1 = (c0 + 255) >> 8; t2 = t1 + ((c1 + 255) >> 8); t3 = t2 + ((c2 + 255) >> 8); t4 = t3 + ((c3 + 255) >> 8); t5 = t4 + ((c4 + 255) >> 8); t6 = t5 + ((c5 + 255) >> 8); t7 = t6 + ((c6 + 255) >> 8);
        nM = t7 + ((c7 + 255) >> 8); nN = nN_; G = G_; c = c_; bexp = bexp_;
    }
    __device__ __forceinline__ bool next(int i, Unit& u) const {
        const long L = (long)i * G + c; if (L >= (long)nM * nN) return false;
        tile_of((int)L, nM, nN, u.pm, u.pn);
        const int pm = u.pm; const int e = (pm >= t1) + (pm >= t2) + (pm >= t3) + (pm >= t4) + (pm >= t5) + (pm >= t6) + (pm >= t7);
        const int tb = e == 0 ? 0 : e == 1 ? t1 : e == 2 ? t2 : e == 3 ? t3 : e == 4 ? t4 : e == 5 ? t5 : e == 6 ? t6 : t7;
        const int ce = e == 0 ? c0 : e == 1 ? c1 : e == 2 ? c2 : e == 3 ? c3 : e == 4 ? c4 : e == 5 ? c5 : e == 6 ? c6 : c7;
        const int left = ce - (pm - tb) * BM;
        u.e = e; u.rows = left < BM ? left : BM; u.arow = pm * BM; u.brow = e * bexp + u.pn * BM; return true;
    }
};

__device__ __forceinline__ f32x2 gelu_pk(f32x2 v) {
    const f32x2 av = __builtin_elementwise_abs(v), d = av * 0.2316418882f + 1.0f;
    f32x2 t; t.x = __builtin_amdgcn_rcpf(d.x); t.y = __builtin_amdgcn_rcpf(d.y);
    f32x2 q = t * 0.5307027145f + (-0.7265760135f); q = q * t + 0.7107068705f; q = q * t + (-0.142248368f); q = q * t + 0.127414796f; q = q * t;
    const f32x2 s = (v * v) * (-0.72134752044f);
    f32x2 e; e.x = __builtin_amdgcn_exp2f(s.x); e.y = __builtin_amdgcn_exp2f(s.y);
    const f32x2 m = v * (q * e), r = v - m;
    f32x2 o; o.x = v.x < 0.f ? m.x : r.x; o.y = v.y < 0.f ? m.y : r.y; return o;
}
__device__ __forceinline__ float silu_f(float v) { return v * __builtin_amdgcn_rcpf(1.0f + __builtin_amdgcn_exp2f(-LOG2E * v)); }

typedef f32x4 Acc[2][2][4][2];
struct EpiGeluZ { static constexpr bool PERM = true;
    unsigned short* Z; const u64* ss; u64* ssv;
    __device__ __forceinline__ void operator()(const Acc& acc, const Unit& u, int wr, int wc, int fr, int fq) const {
        const int row0 = u.pm * BM + wr * 64 + fr, col0 = u.pn * BM + wc * 32 + 8 * fq; const bool isv = u.pn >= (HALFC / BM);
#pragma unroll
        for (int ai = 0; ai < 2; ++ai)
#pragma unroll
            for (int m = 0; m < 4; ++m) { const int row = row0 + ai * HALF + m * 16; const float r = rs_of(ss, row, 1.0f / D); float q = 0.f;
                unsigned short* rowp = Z + (size_t)row * DFF + col0;
#pragma unroll
                for (int bj = 0; bj < 2; ++bj) { const f32x4 v0 = acc[ai][bj][m][0] * r, v1 = acc[ai][bj][m][1] * r;
                    const f32x2 a = gelu_pk((f32x2){v0[0], v0[1]}), b = gelu_pk((f32x2){v0[2], v0[3]}), c = gelu_pk((f32x2){v1[0], v1[1]}), d = gelu_pk((f32x2){v1[2], v1[3]});
                    q += (a.x * a.x + a.y * a.y) + (b.x * b.x + b.y * b.y) + (c.x * c.x + c.y * c.y) + (d.x * d.x + d.y * d.y);
                    u32x4 w; w.x = cvt_pk_bf16(a.x, a.y); w.y = cvt_pk_bf16(b.x, b.y); w.z = cvt_pk_bf16(c.x, c.y); w.w = cvt_pk_bf16(d.x, d.y);
                    *(u32x4*)(rowp + bj * HALF) = w; }
                if (isv) { q += __shfl_xor(q, 16); q += __shfl_xor(q, 32); if (fq == 0) ss_add(ssv, row, q); } }
    }
};
struct EpiResid { static constexpr bool PERM = false;
    const float* base; float* out; unsigned short* XB; u64* ss;
    __device__ __forceinline__ void operator()(const Acc& acc, const Unit& u, int wr, int wc, int fr, int fq) const {
        const int row0 = u.pm * BM + wr * 64 + fr, col0 = u.pn * BM + wc * 32 + 4 * fq;
#pragma unroll
        for (int ai = 0; ai < 2; ++ai)
#pragma unroll
            for (int mp = 0; mp < 2; ++mp) {
                f32x4 pre[2][2][2];
#pragma unroll
                for (int mm = 0; mm < 2; ++mm) { const size_t off = (size_t)(row0 + ai * HALF + (mp * 2 + mm) * 16) * D + col0;
#pragma unroll
                    for (int bj = 0; bj < 2; ++bj)
#pragma unroll
                        for (int n = 0; n < 2; ++n) pre[mm][bj][n] = *(const f32x4*)(base + off + bj * HALF + n * 16); }
                asm volatile("" ::: "memory");
#pragma unroll
                for (int mm = 0; mm < 2; ++mm) { const int m = mp * 2 + mm, row = row0 + ai * HALF + m * 16; const size_t off = (size_t)row * D + col0; float q = 0.f;
#pragma unroll
                    for (int bj = 0; bj < 2; ++bj)
#pragma unroll
                        for (int n = 0; n < 2; ++n) { const f32x4 o = pre[mm][bj][n] + acc[ai][bj][m][n];
                            *(f32x4*)(out + off + bj * HALF + n * 16) = o; q += (o[0] * o[0] + o[1] * o[1]) + (o[2] * o[2] + o[3] * o[3]);
                            if (XB) { u32x2 w; w.x = cvt_pk_bf16(o[0], o[1]); w.y = cvt_pk_bf16(o[2], o[3]); *(u32x2*)(XB + off + bj * HALF + n * 16) = w; } }
                    if (ss) { q += __shfl_xor(q, 16); q += __shfl_xor(q, 32); if (fq == 0) ss_add(ss, row, q); } }
                asm volatile("" ::: "memory");
            }
    }
};
struct EpiSwiglu { static constexpr bool PERM = true;
    unsigned short* H; int ldo; const u64* ss;
    __device__ __forceinline__ void operator()(const Acc& acc, const Unit& u, int wr, int wc, int fr, int fq) const {
        const int row0 = u.pm * BM + wr * 64 + fr, col0 = u.pn * HALF + wc * 32 + 8 * fq, lrow0 = wr * 64 + fr;
#pragma unroll
        for (int ai = 0; ai < 2; ++ai)
#pragma unroll
            for (int m = 0; m < 4; ++m) { const int row = row0 + ai * HALF + m * 16; const float r = ss ? rs_of(ss, row, 1.0f / D) : 1.0f;
                const f32x4 g0 = acc[ai][0][m][0] * r, g1 = acc[ai][0][m][1] * r, u0 = acc[ai][1][m][0] * r, u1 = acc[ai][1][m][1] * r;
                u32x4 w; w.x = cvt_pk_bf16(silu_f(g0[0]) * u0[0], silu_f(g0[1]) * u0[1]); w.y = cvt_pk_bf16(silu_f(g0[2]) * u0[2], silu_f(g0[3]) * u0[3]);
                w.z = cvt_pk_bf16(silu_f(g1[0]) * u1[0], silu_f(g1[1]) * u1[1]); w.w = cvt_pk_bf16(silu_f(g1[2]) * u1[2], silu_f(g1[3]) * u1[3]);
                if (lrow0 + ai * HALF + m * 16 < u.rows) *(u32x4*)(H + (size_t)row * ldo + col0) = w; }
    }
};
struct EpiQKV { static constexpr bool PERM = true;
    unsigned short* Q; size_t tstride; const u64* ss; float qscale;
    __device__ __forceinline__ void operator()(const Acc& acc, const Unit& u, int wr, int wc, int fr, int fq) const {
        const int t = u.pn >> 2; unsigned short* base = Q + (size_t)t * tstride; const float sc = t == 0 ? qscale : 1.0f;
        const int row0 = u.pm * BM + wr * 64 + fr, col0 = (u.pn & 3) * BM + wc * 32 + 8 * fq;
#pragma unroll
        for (int ai = 0; ai < 2; ++ai)
#pragma unroll
            for (int m = 0; m < 4; ++m) { const int row = row0 + ai * HALF + m * 16; const float r = rs_of(ss, row, 1.0f / D) * sc;
                unsigned short* rowp = base + (size_t)row * D + col0;
#pragma unroll
                for (int bj = 0; bj < 2; ++bj) { const f32x4 v0 = acc[ai][bj][m][0] * r, v1 = acc[ai][bj][m][1] * r;
                    u32x4 w; w.x = cvt_pk_bf16(v0[0], v0[1]); w.y = cvt_pk_bf16(v0[2], v0[3]); w.z = cvt_pk_bf16(v1[0], v1[1]); w.w = cvt_pk_bf16(v1[2], v1[3]);
                    *(u32x4*)(rowp + bj * HALF) = w; } }
    }
};
struct EpiMoe2 { static constexpr bool PERM = true;
    unsigned short* Y; const float* slotw;
    __device__ __forceinline__ void operator()(const Acc& acc, const Unit& u, int wr, int wc, int fr, int fq) const {
        const int row0 = u.pm * BM + wr * 64 + fr, col0 = u.pn * BM + wc * 32 + 8 * fq, lrow0 = wr * 64 + fr;
#pragma unroll
        for (int ai = 0; ai < 2; ++ai)
#pragma unroll
            for (int m = 0; m < 4; ++m) { const int row = row0 + ai * HALF + m * 16; const bool ok = lrow0 + ai * HALF + m * 16 < u.rows; const float r = ok ? slotw[row] : 0.f;
                unsigned short* rowp = Y + (size_t)row * D + col0;
#pragma unroll
                for (int bj = 0; bj < 2; ++bj) { const f32x4 v0 = acc[ai][bj][m][0] * r, v1 = acc[ai][bj][m][1] * r;
                    u32x4 w; w.x = cvt_pk_bf16(v0[0], v0[1]); w.y = cvt_pk_bf16(v0[2], v0[3]); w.z = cvt_pk_bf16(v1[0], v1[1]); w.w = cvt_pk_bf16(v1[2], v1[3]);
                    if (ok) *(u32x4*)(rowp + bj * HALF) = w; } }
    }
};

template <class Epi, class Sched, bool ALIGN_EPI>
__device__ __forceinline__ void gemm_phase(LAS unsigned char* lds, const char* Abase, const char* Bbase, int K, int lda, int ldb, const Sched& S, const Epi& E) {
    const int tid = threadIdx.x, wid = __builtin_amdgcn_readfirstlane(tid >> 6), lane = tid & 63, wr = wid >> 2, wc = wid & 3, fr = lane & 15, fq = lane >> 4;
    const int nt = K / BK;
    unsigned voffA[2], voffB[2];
#pragma unroll
    for (int i = 0; i < 2; ++i) { int R, C; stage_rc(tid * 16 + i * 8192, R, C); const int Rb = Epi::PERM ? ((R & ~31) + perm32(R & 31)) : R;
        voffA[i] = (unsigned)(R * lda + C * 2); voffB[i] = (unsigned)(Rb * ldb + C * 2); }
    const size_t kstep = (size_t)(BK * 2);
    const size_t hstepA = (size_t)HALF * lda, hstepB = (size_t)HALF * ldb;
    const unsigned ldsw = (unsigned)wid * 1024u;
    const int aoff = lds_byte(wr * 64 + fr, fq * 8), boff = lds_byte(wc * 32 + fr, fq * 8);
#define PG8_SA(b, h) (((b) * 2 + (h)) * HTB)
#define PG8_SB(b, h) ((4 + (b) * 2 + (h)) * HTB)
#define PG8_STAGE(bufoff, gbase, voff) do { _Pragma("unroll") for (int _i = 0; _i < 2; ++_i) \
        __builtin_amdgcn_global_load_lds((const unsigned*)((const char*)(gbase) + (voff)[_i]), (LAS unsigned*)(lds + (bufoff) + ldsw + _i * 8192), 16, 0, 0); } while (0)
#define PG8_LDA(dst, b, h) do { _Pragma("unroll") for (int m = 0; m < 4; ++m) _Pragma("unroll") for (int k = 0; k < 2; ++k) dst[m][k] = *(const LAS bf16x8*)(lds + PG8_SA(b, h) + aoff + m * 2048 + k * 1024); } while (0)
#define PG8_LDB(dst, b, h) do { _Pragma("unroll") for (int n = 0; n < 2; ++n) _Pragma("unroll") for (int k = 0; k < 2; ++k) dst[n][k] = *(const LAS bf16x8*)(lds + PG8_SB(b, h) + boff + n * 2048 + k * 1024); } while (0)
#define PG8_MMA(ai, bj, At, Bt) do { __builtin_amdgcn_s_setprio(1); _Pragma("unroll") for (int m = 0; m < 4; ++m) _Pragma("unroll") for (int n = 0; n < 2; ++n) _Pragma("unroll") for (int k = 0; k < 2; ++k) \
        acc[ai][bj][m][n] = __builtin_amdgcn_mfma_f32_16x16x32_bf16(Bt[n][k], At[m][k], acc[ai][bj][m][n], 0, 0, 0); __builtin_amdgcn_s_setprio(0); } while (0)
#define PG8_WAIT_V(n) asm volatile("s_waitcnt vmcnt(" #n ")" ::: "memory")
#define PG8_WAIT_L(n) asm volatile("s_waitcnt lgkmcnt(" #n ")" ::: "memory")
#define PG8_BAR __builtin_amdgcn_s_barrier()
#define PG8_SCHED __builtin_amdgcn_sched_barrier(0)
    Unit cur, nxt; int ui = 0;
    if (!S.next(0, cur)) return;
    Acc acc;
#pragma unroll
    for (int a = 0; a < 2; ++a)
#pragma unroll
        for (int b = 0; b < 2; ++b)
#pragma unroll
            for (int m = 0; m < 4; ++m)
#pragma unroll
                for (int n = 0; n < 2; ++n) acc[a][b][m][n] = (f32x4){0.f, 0.f, 0.f, 0.f};
    bf16x8 At[4][2], B0[2][2], B1[2][2];
    const char* cA = Abase + (size_t)cur.arow * lda; const char* cB = Bbase + (size_t)cur.brow * ldb;
    PG8_STAGE(PG8_SB(0, 0), cB, voffB); PG8_STAGE(PG8_SB(0, 1), cB + hstepB, voffB); PG8_STAGE(PG8_SA(0, 0), cA, voffA); PG8_STAGE(PG8_SA(0, 1), cA + hstepA, voffA);
    if (wr == 1) PG8_BAR;
    PG8_WAIT_V(2); PG8_BAR;
    PG8_STAGE(PG8_SB(1, 0), cB + kstep, voffB); PG8_STAGE(PG8_SA(1, 0), cA + kstep, voffA); PG8_STAGE(PG8_SB(1, 1), cB + hstepB + kstep, voffB);
    PG8_WAIT_V(6); PG8_BAR;
    for (;;) {
        const bool has_next = S.next(ui + 1, nxt);
        const char* nA = has_next ? Abase + (size_t)nxt.arow * lda : cA; const char* nB = has_next ? Bbase + (size_t)nxt.brow * ldb : cB;
        for (int t = 0; t < nt; t += 2) {
            const bool last = (t == nt - 2);
            const char* a1 = cA + (size_t)(t + 1) * kstep;
            const char* a2 = last ? nA : cA + (size_t)(t + 2) * kstep; const char* b2 = last ? nB : cB + (size_t)(t + 2) * kstep;
            const char* a3 = a2 + kstep; const char* b3 = b2 + kstep;
            PG8_LDB(B0, 0, 0); PG8_LDB(B1, 0, 1); PG8_SCHED; PG8_LDA(At, 0, 0); PG8_STAGE(PG8_SA(1, 1), a1 + hstepA, voffA);
            PG8_WAIT_V(8); PG8_WAIT_L(0); PG8_BAR; PG8_MMA(0, 0, At, B0); PG8_MMA(0, 1, At, B1); PG8_BAR; PG8_SCHED;
            PG8_LDA(At, 0, 1); PG8_STAGE(PG8_SB(0, 0), b2, voffB); PG8_STAGE(PG8_SB(0, 1), b2 + hstepB, voffB); PG8_STAGE(PG8_SA(0, 0), a2, voffA);
            PG8_WAIT_V(8); PG8_WAIT_L(0); PG8_BAR; PG8_MMA(1, 0, At, B0); PG8_MMA(1, 1, At, B1); PG8_BAR; PG8_SCHED;
            PG8_LDB(B0, 1, 0); PG8_LDB(B1, 1, 1); PG8_SCHED; PG8_LDA(At, 1, 0); PG8_STAGE(PG8_SA(0, 1), a2 + hstepA, voffA);
            PG8_WAIT_V(8); PG8_WAIT_L(0); PG8_BAR; PG8_MMA(0, 0, At, B0); PG8_MMA(0, 1, At, B1); PG8_BAR; PG8_SCHED;
            PG8_LDA(At, 1, 1); PG8_STAGE(PG8_SB(1, 0), b3, voffB); PG8_STAGE(PG8_SB(1, 1), b3 + hstepB, voffB); PG8_STAGE(PG8_SA(1, 0), a3, voffA);
            PG8_WAIT_V(8); PG8_WAIT_L(0); PG8_BAR; PG8_MMA(1, 0, At, B0); PG8_MMA(1, 1, At, B1); PG8_BAR; PG8_SCHED;
        }
        if constexpr (ALIGN_EPI) { if (wr == 0) PG8_BAR; }
        E(acc, cur, wr, wc, fr, fq);
        if (!has_next) break;
#pragma unroll
        for (int a = 0; a < 2; ++a)
#pragma unroll
            for (int b = 0; b < 2; ++b)
#pragma unroll
                for (int m = 0; m < 4; ++m)
#pragma unroll
                    for (int n = 0; n < 2; ++n) acc[a][b][m][n] = (f32x4){0.f, 0.f, 0.f, 0.f};
        cur = nxt; cA = nA; cB = nB; ++ui;
        if constexpr (ALIGN_EPI) { if (wr == 1) PG8_BAR; }
    }
    PG8_WAIT_V(0);
    if constexpr (!ALIGN_EPI) { if (wr == 0) PG8_BAR; }
    PG8_BAR;
#undef PG8_SA
#undef PG8_SB
#undef PG8_STAGE
#undef PG8_LDA
#undef PG8_LDB
#undef PG8_MMA
#undef PG8_WAIT_V
#undef PG8_WAIT_L
#undef PG8_BAR
#undef PG8_SCHED
}

struct Args {
    const float* in[20]; float* out; unsigned char* ws; int ph_lo, ph_hi; int flags, pad;
};
struct Frame {
    LAS unsigned char* lds; volatile LAS unsigned* MISC; unsigned char* ws; gu32* ctl;
    int tid, lane, wave, vcu, G;
};

__device__ __forceinline__ void tr_item(const float* W, int N, int k0, int n0, unsigned short* WT, int ldt, int row0, const float* gain, LAS float* scr, int lane) {
    const int r = lane >> 5, c2 = lane & 31;
#pragma unroll 8
    for (int i = 0; i < 32; ++i) { const int kk = 2 * i + r; f32x2 v = *(const f32x2*)(W + (size_t)(k0 + kk) * N + n0 + 2 * c2); if (gain) { const float gk = gain[k0 + kk]; v = v * gk; }
        scr[kk * 65 + 2 * c2] = v.x; scr[kk * 65 + 2 * c2 + 1] = v.y; }
    LDS_WAIT(); asm volatile("" ::: "memory");
    const int c = lane & 7;
#pragma unroll
    for (int j = 0; j < 8; ++j) { const int n = (lane >> 3) + 8 * j; const LAS float* s = scr + (8 * c) * 65 + n;
        u32x4 o; o.x = cvt_pk_bf16(s[0 * 65], s[1 * 65]); o.y = cvt_pk_bf16(s[2 * 65], s[3 * 65]); o.z = cvt_pk_bf16(s[4 * 65], s[5 * 65]); o.w = cvt_pk_bf16(s[6 * 65], s[7 * 65]);
        *(u32x4*)(WT + (size_t)(row0 + n) * ldt + k0 + 8 * c) = o; }
    LDS_WAIT(); asm volatile("" ::: "memory");
}
__device__ __forceinline__ void tr_plain(const float* W, int K, int N, unsigned short* WT, const float* gain, LAS float* scr, int item, int lane) {
    const int nblk = N / 64, kb = item / nblk, nb = item % nblk; tr_item(W, N, kb * 64, nb * 64, WT, K, nb * 64, gain, scr, lane);
}
__device__ __forceinline__ void tr_inter(const float* W, int K, int N, unsigned short* WT, int up, const float* gain, LAS float* scr, int item, int lane) {
    const int nblk = N / 64, kb = item / nblk, nb = item % nblk, n0 = nb * 64; tr_item(W, N, kb * 64, n0, WT, K, 256 * (n0 >> 7) + (n0 & 127) + up * 128, gain, scr, lane);
}
__device__ __forceinline__ void xb_row(const float* xrow, unsigned short* orow, u64* ssp, int lane) {
    const f32x4* xr = (const f32x4*)xrow + lane; f32x4 v[4]; float s = 0.f;
#pragma unroll
    for (int j = 0; j < 4; ++j) { v[j] = xr[64 * j]; s += (v[j].x * v[j].x + v[j].y * v[j].y) + (v[j].z * v[j].z + v[j].w * v[j].w); }
    s = wave_sum(s);
    u32x2* o8 = (u32x2*)orow + lane;
#pragma unroll
    for (int j = 0; j < 4; ++j) { u32x2 w; w.x = cvt_pk_bf16(v[j].x, v[j].y); w.y = cvt_pk_bf16(v[j].z, v[j].w); o8[64 * j] = w; }
    if (lane == 0) *ssp = (u64)(s * SS_SCALE);
}

constexpr int FL_EXPERTS = 1, FL_L0 = 2, FL_QSCALE1 = 4;

__device__ __forceinline__ void p0_prologue(Frame& F, const Args& a) {
    LAS float* scr = (LAS float*)(F.lds + F.wave * 16640);
    const int gw = F.vcu * NWAVES + F.wave, NGW = F.G * NWAVES;
    constexpr int I_IN = 16 * 96, I_OUT = 48 * 16, I_G = 16 * 44, I_D = 44 * 16, I_QKV = 16 * 48, I_O = 16 * 16, I_EG = 16 * 56, I_ED = 56 * 16;
    unsigned char* ws = F.ws;
    if (a.flags & FL_L0) {
        constexpr int NIT = I_IN + I_OUT + 2 * I_G + I_D + I_QKV + I_O;
        for (int it = gw; it < NIT; it += NGW) {
            int r = it;
            if (r < I_IN) { tr_plain(a.in[4], D, DFF, (unsigned short*)(ws + WS_WIN), a.in[1], scr, r, F.lane); continue; } r -= I_IN;
            if (r < I_OUT) { tr_plain(a.in[8], HALFC, D, (unsigned short*)(ws + WS_WOUT), nullptr, scr, r, F.lane); continue; } r -= I_OUT;
            if (r < I_G) { tr_inter(a.in[9], D, FFN, (unsigned short*)(ws + WS_WGU), 0, a.in[2], scr, r, F.lane); continue; } r -= I_G;
            if (r < I_G) { tr_inter(a.in[10], D, FFN, (unsigned short*)(ws + WS_WGU), 1, a.in[2], scr, r, F.lane); continue; } r -= I_G;
            if (r < I_D) { tr_plain(a.in[11], FFN, D, (unsigned short*)(ws + WS_WD), nullptr, scr, r, F.lane); continue; } r -= I_D;
            if (r < I_QKV) { tr_plain(a.in[12], D, 3 * D, (unsigned short*)(ws + WS_WQKV), a.in[1] + D, scr, r, F.lane); continue; } r -= I_QKV;
            tr_plain(a.in[14], D, D, (unsigned short*)(ws + WS_WO), nullptr, scr, r, F.lane);
        }
        for (int m = gw; m < T; m += NGW) xb_row(a.in[0] + (size_t)m * D, (unsigned short*)(ws + WS_XB) + (size_t)m * D, (u64*)(ws + WS_SS0) + m, F.lane);
    }
    if (a.flags & FL_EXPERTS) {
        constexpr int NIT = NE * (2 * I_EG + I_ED);
        for (int it = gw; it < NIT; it += NGW) {
            const int e = it / (2 * I_EG + I_ED); int r = it % (2 * I_EG + I_ED);
            if (r < I_EG) { tr_inter(a.in[17] + (size_t)e * D * EDIM, D, EDIM, (unsigned short*)(ws + WS_WEGU) + (size_t)e * 2 * EDIM * D, 0, nullptr, scr, r, F.lane); continue; } r -= I_EG;
            if (r < I_EG) { tr_inter(a.in[18] + (size_t)e * D * EDIM, D, EDIM, (unsigned short*)(ws + WS_WEGU) + (size_t)e * 2 * EDIM * D, 1, nullptr, scr, r, F.lane); continue; } r -= I_EG;
            tr_plain(a.in[19] + (size_t)e * EDIM * D, EDIM, D, (unsigned short*)(ws + WS_WED) + (size_t)e * D * EDIM, nullptr, scr, r, F.lane);
        }
    }
}

__device__ __forceinline__ void p9_router(Frame& F, const Args& a) {
    LAS float* rw = (LAS float*)F.lds;
    for (int i = F.tid; i < D * NE / 4; i += NWAVES * 64) ((LAS f32x4*)rw)[i] = ((const f32x4*)a.in[15])[i];
    LDS_WAIT(); __syncthreads();
    const float* g = a.in[2] + D; const float* rb = a.in[16];
    int* cnt = (int*)(F.ctl + CW_CNT); int* list = (int*)(F.ws + WS_LIST); int* tokslot = (int*)(F.ws + WS_TOKSLOT); float* tokw = (float*)(F.ws + WS_TOKW); float* r3 = (float*)(F.ws + WS_R3);
    const int gw = F.vcu * NWAVES + F.wave, NGW = F.G * NWAVES;
    for (int t = gw; t < T; t += NGW) {
        const float* xr = a.out + (size_t)t * D; float lg[NE]; float s = 0.f;
#pragma unroll
        for (int e = 0; e < NE; ++e) lg[e] = 0.f;
#pragma unroll 4
        for (int j = 0; j < 16; ++j) { const int k = F.lane + 64 * j; const float xv = xr[k]; s += xv * xv; const float hv = xv * g[k];
            const f32x4 w0 = *(const LAS f32x4*)(rw + k * 8), w1 = *(const LAS f32x4*)(rw + k * 8 + 4);
            lg[0] += hv * w0.x; lg[1] += hv * w0.y; lg[2] += hv * w0.z; lg[3] += hv * w0.w; lg[4] += hv * w1.x; lg[5] += hv * w1.y; lg[6] += hv * w1.z; lg[7] += hv * w1.w; }
        s = wave_sum(s); const float r = rsqrtf(s * (1.0f / D) + EPS);
#pragma unroll
        for (int e = 0; e < NE; ++e) lg[e] = wave_sum(lg[e]) * r + rb[e];
        if (F.lane == 0) {
            int e1 = 0; float v1 = lg[0];
#pragma unroll
            for (int e = 1; e < NE; ++e) if (lg[e] > v1) { v1 = lg[e]; e1 = e; }
            int e2 = -1; float v2 = -3.0e38f;
#pragma unroll
            for (int e = 0; e < NE; ++e) if (e != e1 && lg[e] > v2) { v2 = lg[e]; e2 = e; }
            const float w2 = 1.0f / (1.0f + __expf(v1 - v2)), w1 = 1.0f - w2;
            const int p1 = __hip_atomic_fetch_add(cnt + e1, 1, RLX_AGENT), p2 = __hip_atomic_fetch_add(cnt + e2, 1, RLX_AGENT);
            list[e1 * T + p1] = t; list[e2 * T + p2] = t;
            tokslot[t * 4 + 0] = e1; tokslot[t * 4 + 1] = p1; tokslot[t * 4 + 2] = e2; tokslot[t * 4 + 3] = p2;
            tokw[t * 2 + 0] = w1; tokw[t * 2 + 1] = w2; r3[t] = r;
        }
    }
}
__device__ __forceinline__ int slot_base(const int* cnt, int e) {
    int o = 0;
#pragma unroll
    for (int j = 0; j < NE; ++j) { const int c = ((cnt[j] + 255) >> 8) << 8; o += (j < e) ? c : 0; }
    return o;
}
__device__ __forceinline__ void p9b_gather(Frame& F, const Args& a) {
    const float* g = a.in[2] + D; const int* cnt = (const int*)(F.ctl + CW_CNT); const int* tokslot = (const int*)(F.ws + WS_TOKSLOT); const float* tokw = (const float*)(F.ws + WS_TOKW);
    const float* r3 = (const float*)(F.ws + WS_R3); float* slotw = (float*)(F.ws + WS_SLOTW); unsigned short* XG = (unsigned short*)(F.ws + WS_XG);
    const int gw = F.vcu * NWAVES + F.wave, NGW = F.G * NWAVES;
    for (int t = gw; t < T; t += NGW) {
        const int e1 = tokslot[t * 4], p1 = tokslot[t * 4 + 1], e2 = tokslot[t * 4 + 2], p2 = tokslot[t * 4 + 3];
        const size_t s1 = (size_t)slot_base(cnt, e1) + p1, s2 = (size_t)slot_base(cnt, e2) + p2; const float r = r3[t];
        const f32x4* xr = (const f32x4*)(a.out + (size_t)t * D) + F.lane; const f32x4* gr = (const f32x4*)g + F.lane;
        u32x2* o1 = (u32x2*)(XG + s1 * D) + F.lane; u32x2* o2 = (u32x2*)(XG + s2 * D) + F.lane;
#pragma unroll
        for (int j = 0; j < 4; ++j) { const f32x4 v = xr[64 * j] * gr[64 * j] * r; u32x2 w; w.x = cvt_pk_bf16(v.x, v.y); w.y = cvt_pk_bf16(v.z, v.w); o1[64 * j] = w; o2[64 * j] = w; }
        if (F.lane == 0) { slotw[s1] = tokw[t * 2]; slotw[s2] = tokw[t * 2 + 1]; }
    }
}
__device__ __forceinline__ void p12_final(Frame& F, const Args& a) {
    const int* cnt = (const int*)(F.ctl + CW_CNT); const int* tokslot = (const int*)(F.ws + WS_TOKSLOT); const unsigned short* Y = (const unsigned short*)(F.ws + WS_Y);
    const f32x4* gr = (const f32x4*)a.in[3] + F.lane;
    const int gw = F.vcu * NWAVES + F.wave, NGW = F.G * NWAVES;
    for (int t = gw; t < T; t += NGW) {
        const int e1 = tokslot[t * 4], p1 = tokslot[t * 4 + 1], e2 = tokslot[t * 4 + 2], p2 = tokslot[t * 4 + 3];
        const size_t s1 = (size_t)slot_base(cnt, e1) + p1, s2 = (size_t)slot_base(cnt, e2) + p2;
        f32x4* xr = (f32x4*)(a.out + (size_t)t * D) + F.lane; const u32x2* y1 = (const u32x2*)(Y + s1 * D) + F.lane; const u32x2* y2 = (const u32x2*)(Y + s2 * D) + F.lane;
        f32x4 v[4]; float s = 0.f;
#pragma unroll
        for (int j = 0; j < 4; ++j) { const u32x2 a1 = y1[64 * j], a2 = y2[64 * j]; f32x4 x = xr[64 * j];
            x.x += __uint_as_float(a1.x << 16) + __uint_as_float(a2.x << 16); x.y += __uint_as_float(a1.x & 0xffff0000u) + __uint_as_float(a2.x & 0xffff0000u);
            x.z += __uint_as_float(a1.y << 16) + __uint_as_float(a2.y << 16); x.w += __uint_as_float(a1.y & 0xffff0000u) + __uint_as_float(a2.y & 0xffff0000u);
            v[j] = x; s += (x.x * x.x + x.y * x.y) + (x.z * x.z + x.w * x.w); }
        const float r = rsqrtf(wave_sum(s) * (1.0f / D) + EPS);
#pragma unroll
        for (int j = 0; j < 4; ++j) xr[64 * j] = v[j] * gr[64 * j] * r;
    }
}


typedef short v4i16_t __attribute__((ext_vector_type(4)));
__device__ __forceinline__ s16x4 lds_tr(LAS unsigned char* p) { return __builtin_bit_cast(s16x4, __builtin_amdgcn_ds_read_tr16_b64_v4i16((LAS v4i16_t*)p)); }
__device__ __forceinline__ void p2_gating(Frame& F, const Args& a) {
    constexpr int VS = 272;
    LAS unsigned char* Vl = F.lds; LAS unsigned char* Wl = F.lds + 128 * VS; LAS float* rsl = (LAS float*)(F.lds + 2 * 128 * VS);
    unsigned short* Z = (unsigned short*)(F.ws + WS_Z); const u64* ssv = (const u64*)(F.ws + WS_SSV);
    const float* gain = a.in[5]; const float* wsp = a.in[6]; const float* bsp = a.in[7];
    const int tid = F.tid, lane = F.lane, wave = F.wave, th = wave >> 2, wc = wave & 3, fr = lane & 15, fq = lane >> 4;
    constexpr int NU = (T / GBLK) * (HALFC / 128);
    const int per = (NU % F.G == 0) ? NU / F.G : 0;
    for (int i = 0;; ++i) {
        int un; if (per) { if (i >= per) break; un = F.vcu * per + i; } else { un = i * F.G + F.vcu; if (un >= NU) break; }
        const int blk = un / 24, slab = un % 24, g = slab / 3;
        u32x4 vr[4];
#pragma unroll
        for (int j = 0; j < 4; ++j) { const int id = tid + 512 * j, row = id >> 4, ch = id & 15;
            vr[j] = *(const u32x4*)(Z + (size_t)(blk * GBLK + row) * DFF + HALFC + slab * 128 + ch * 8); }
        if (tid < GBLK) rsl[tid] = rs_of(ssv, blk * GBLK + tid, 1.0f / HALFC);
        LDS_WAIT(); __syncthreads();
        { const int t = tid >> 2, s0 = (tid & 3) * 32; const f32x4* wrow = (const f32x4*)(wsp + ((size_t)g * GBLK + t) * GBLK + s0);
#pragma unroll
            for (int j = 0; j < 4; ++j) { const f32x4 w0 = wrow[2 * j], w1 = wrow[2 * j + 1]; const f32x4 r0 = *(const LAS f32x4*)(rsl + s0 + 8 * j), r1 = *(const LAS f32x4*)(rsl + s0 + 8 * j + 4);
                u32x4 o; o.x = cvt_pk_bf16(w0.x * r0.x, w0.y * r0.y); o.y = cvt_pk_bf16(w0.z * r0.z, w0.w * r0.w); o.z = cvt_pk_bf16(w1.x * r1.x, w1.y * r1.y); o.w = cvt_pk_bf16(w1.z * r1.z, w1.w * r1.w);
                *(LAS u32x4*)(Wl + t * VS + (s0 + 8 * j) * 2) = o; } }
#pragma unroll
        for (int j = 0; j < 4; ++j) { const int id = tid + 512 * j, row = id >> 4, ch = id & 15; *(LAS u32x4*)(Vl + row * VS + ch * 16) = vr[j]; }
        u32x4 uu[4]; float bb[4];
        const int c0 = slab * 128 + wc * 32 + 8 * fq;
#pragma unroll
        for (int m = 0; m < 4; ++m) { const int t = 64 * th + 16 * m + fr; uu[m] = *(const u32x4*)(Z + (size_t)(blk * GBLK + t) * DFF + c0); bb[m] = bsp[g * GBLK + t]; }
        const f32x4 ga = *(const f32x4*)(gain + c0), gb = *(const f32x4*)(gain + c0 + 4);
        LDS_WAIT(); __syncthreads();
        f32x4 acc[4][2];
#pragma unroll
        for (int m = 0; m < 4; ++m) { acc[m][0] = (f32x4){0.f, 0.f, 0.f, 0.f}; acc[m][1] = (f32x4){0.f, 0.f, 0.f, 0.f}; }
        const int nks = th ? 4 : 2;
        LAS unsigned char* vbase = Vl + (8 * fq + (fr >> 2)) * VS + (wc * 32 + 8 * (fr & 3)) * 2;
        LAS unsigned char* wbase = Wl + (64 * th + fr) * VS + (8 * fq) * 2;
        for (int ks = 0; ks < nks; ++ks) {
            bf16x8 vf[2], wf[4];
#pragma unroll
            for (int n = 0; n < 2; ++n) { const s16x4 lo = lds_tr(vbase + (32 * ks) * VS + n * 8), hi = lds_tr(vbase + (32 * ks + 4) * VS + n * 8);
                vf[n] = (bf16x8){lo[0], lo[1], lo[2], lo[3], hi[0], hi[1], hi[2], hi[3]}; }
#pragma unroll
            for (int m = 0; m < 4; ++m) wf[m] = *(const LAS bf16x8*)(wbase + (16 * m) * VS + (32 * ks) * 2);
#pragma unroll
            for (int m = 0; m < 4; ++m)
#pragma unroll
                for (int n = 0; n < 2; ++n) acc[m][n] = __builtin_amdgcn_mfma_f32_16x16x32_bf16(vf[n], wf[m], acc[m][n], 0, 0, 0);
        }
#pragma unroll
        for (int m = 0; m < 4; ++m) { const int t = 64 * th + 16 * m + fr; const f32x4 s0 = acc[m][0] * ga + bb[m], s1 = acc[m][1] * gb + bb[m]; const u32x4 uv = uu[m];
            u32x4 o;
            o.x = cvt_pk_bf16(__uint_as_float(uv.x << 16) * s0[0], __uint_as_float(uv.x & 0xffff0000u) * s0[1]); o.y = cvt_pk_bf16(__uint_as_float(uv.y << 16) * s0[2], __uint_as_float(uv.y & 0xffff0000u) * s0[3]);
            o.z = cvt_pk_bf16(__uint_as_float(uv.z << 16) * s1[0], __uint_as_float(uv.z & 0xffff0000u) * s1[1]); o.w = cvt_pk_bf16(__uint_as_float(uv.w << 16) * s1[2], __uint_as_float(uv.w & 0xffff0000u) * s1[3]);
            *(u32x4*)(Z + (size_t)(blk * GBLK + t) * DFF + c0) = o; }
        __syncthreads();
    }
}

__device__ __forceinline__ void p7_attention(Frame& F, const Args& a) {
    constexpr int KS = 144;
    constexpr int SLOT = 64 * KS;
    LAS unsigned char* Kl = F.lds; LAS unsigned char* Vl = F.lds + 2 * SLOT; LAS float* bl = (LAS float*)(F.lds + 4 * SLOT);
    const unsigned short* Qg = (const unsigned short*)(F.ws + WS_Q); const unsigned short* Kg = (const unsigned short*)(F.ws + WS_K); const unsigned short* Vg = (const unsigned short*)(F.ws + WS_V);
    unsigned short* Og = (unsigned short*)(F.ws + WS_O); const float* rel = a.in[13];
    const int tid = F.tid, lane = F.lane, w = F.wave, cw = w >> 1, fr = lane & 15, fq = lane >> 4;
    constexpr int NU = NB * NH * (SEQ / 256);
    const int lrow = tid >> 3, lch = tid & 7;
    for (int un = F.vcu; un < NU; un += F.G) {
        const int qb = un & 15, h = (un >> 4) & 15, b = un >> 8;
        const size_t rowb = (size_t)b * SEQ;
        __syncthreads();
        if (tid < RELSZ) bl[tid] = rel[h * RELSZ + tid] * LOG2E;
        bf16x8 qf[2][2];
#pragma unroll
        for (int qt = 0; qt < 2; ++qt)
#pragma unroll
            for (int ks = 0; ks < 2; ++ks) qf[qt][ks] = *(const bf16x8*)(Qg + (rowb + qb * 256 + 32 * w + 16 * qt + fr) * D + h * HD + 32 * ks + 8 * fq);
        f32x4 o[4][2];
#pragma unroll
        for (int dt = 0; dt < 4; ++dt) { o[dt][0] = (f32x4){0.f, 0.f, 0.f, 0.f}; o[dt][1] = (f32x4){0.f, 0.f, 0.f, 0.f}; }
        float mrun[2] = {-1e30f, -1e30f}, lrun[2] = {0.f, 0.f};
        const int jt0 = (4 * qb - 8 < 0) ? (8 - 4 * qb) : 0;
        u32x4 kreg, vreg;
        { const size_t krow = rowb + (size_t)(4 * qb - 8 + jt0) * 64 + lrow; kreg = *(const u32x4*)(Kg + krow * D + h * HD + lch * 8); vreg = *(const u32x4*)(Vg + krow * D + h * HD + lch * 8); }
        *(LAS u32x4*)(Kl + (jt0 & 1) * SLOT + lrow * KS + lch * 16) = kreg; *(LAS u32x4*)(Vl + (jt0 & 1) * SLOT + lrow * KS + lch * 16) = vreg;
        LDS_WAIT(); __syncthreads();
        for (int jt = jt0; jt < 12; ++jt) {
            const bool more = jt + 1 < 12;
            if (more) { const size_t krow = rowb + (size_t)(4 * qb - 8 + jt + 1) * 64 + lrow; kreg = *(const u32x4*)(Kg + krow * D + h * HD + lch * 8); vreg = *(const u32x4*)(Vg + krow * D + h * HD + lch * 8); }
            if (jt >= cw && jt <= cw + 8) {
                LAS unsigned char* Ks_ = Kl + (jt & 1) * SLOT; LAS unsigned char* Vs_ = Vl + (jt & 1) * SLOT;
                f32x4 sc[4][2];
#pragma unroll
                for (int it = 0; it < 4; ++it) { sc[it][0] = (f32x4){0.f, 0.f, 0.f, 0.f}; sc[it][1] = (f32x4){0.f, 0.f, 0.f, 0.f}; }
#pragma unroll
                for (int ks = 0; ks < 2; ++ks)
#pragma unroll
                    for (int it = 0; it < 4; ++it) { const bf16x8 kf = *(const LAS bf16x8*)(Ks_ + (16 * it + fr) * KS + (32 * ks + 8 * fq) * 2);
                        sc[it][0] = __builtin_amdgcn_mfma_f32_16x16x32_bf16(kf, qf[0][ks], sc[it][0], 0, 0, 0);
                        sc[it][1] = __builtin_amdgcn_mfma_f32_16x16x32_bf16(kf, qf[1][ks], sc[it][1], 0, 0, 0); }
                const int dchunk = cw + 8 - jt;
                if (dchunk <= 4) {
#pragma unroll
                    for (int qt = 0; qt < 2; ++qt) { const int qloc = 32 * (w & 1) + 16 * qt + fr;
#pragma unroll
                        for (int it = 0; it < 4; ++it)
#pragma unroll
                            for (int r = 0; r < 4; ++r) { int dist = 64 * dchunk + qloc - (16 * it + 4 * fq + r); dist = dist > RELCLIP ? RELCLIP : dist; sc[it][qt][r] += bl[dist + (CHUNK - 1)]; } }
                } else { const float bc = bl[RELSZ - 1];
#pragma unroll
                    for (int it = 0; it < 4; ++it) { sc[it][0] = sc[it][0] + bc; sc[it][1] = sc[it][1] + bc; } }
                bf16x8 pf[2][2];
#pragma unroll
                for (int qt = 0; qt < 2; ++qt) {
                    float mx = sc[0][qt][0];
#pragma unroll
                    for (int it = 0; it < 4; ++it)
#pragma unroll
                        for (int r = 0; r < 4; ++r) mx = fmaxf(mx, sc[it][qt][r]);
                    mx = fmaxf(mx, __shfl_xor(mx, 16)); mx = fmaxf(mx, __shfl_xor(mx, 32));
                    const float mn = fmaxf(mrun[qt], mx), corr = __builtin_amdgcn_exp2f(mrun[qt] - mn); mrun[qt] = mn;
                    float ps = 0.f; float p[4][4];
#pragma unroll
                    for (int it = 0; it < 4; ++it)
#pragma unroll
                        for (int r = 0; r < 4; ++r) { p[it][r] = __builtin_amdgcn_exp2f(sc[it][qt][r] - mn); ps += p[it][r]; }
                    lrun[qt] = lrun[qt] * corr + ps;
#pragma unroll
                    for (int dt = 0; dt < 4; ++dt) o[dt][qt] = o[dt][qt] * corr;
#pragma unroll
                    for (int kk = 0; kk < 2; ++kk) { u32x4 pk; pk.x = cvt_pk_bf16(p[2 * kk][0], p[2 * kk][1]); pk.y = cvt_pk_bf16(p[2 * kk][2], p[2 * kk][3]); pk.z = cvt_pk_bf16(p[2 * kk + 1][0], p[2 * kk + 1][1]); pk.w = cvt_pk_bf16(p[2 * kk + 1][2], p[2 * kk + 1][3]);
                        pf[kk][qt] = __builtin_bit_cast(bf16x8, pk); }
                }
                LAS unsigned char* vb = Vs_ + (4 * fq + (fr >> 2)) * KS + (4 * (fr & 3)) * 2;
#pragma unroll
                for (int kk = 0; kk < 2; ++kk)
#pragma unroll
                    for (int dt = 0; dt < 4; ++dt) { const s16x4 lo = lds_tr(vb + (32 * kk) * KS + dt * 32), hi = lds_tr(vb + (32 * kk + 16) * KS + dt * 32);
                        const bf16x8 vf = (bf16x8){lo[0], lo[1], lo[2], lo[3], hi[0], hi[1], hi[2], hi[3]};
                        o[dt][0] = __builtin_amdgcn_mfma_f32_16x16x32_bf16(vf, pf[kk][0], o[dt][0], 0, 0, 0);
                        o[dt][1] = __builtin_amdgcn_mfma_f32_16x16x32_bf16(vf, pf[kk][1], o[dt][1], 0, 0, 0); }
            }
            if (more) { *(LAS u32x4*)(Kl + ((jt + 1) & 1) * SLOT + lrow * KS + lch * 16) = kreg; *(LAS u32x4*)(Vl + ((jt + 1) & 1) * SLOT + lrow * KS + lch * 16) = vreg; }
            LDS_WAIT(); __syncthreads();
        }
#pragma unroll
        for (int qt = 0; qt < 2; ++qt) { float l = lrun[qt]; l += __shfl_xor(l, 16); l += __shfl_xor(l, 32); const float inv = 1.0f / l;
            unsigned short* orow = Og + (rowb + qb * 256 + 32 * w + 16 * qt + fr) * D + h * HD + 4 * fq;
#pragma unroll
            for (int dt = 0; dt < 4; ++dt) { const f32x4 v = o[dt][qt] * inv; u32x2 wv; wv.x = cvt_pk_bf16(v[0], v[1]); wv.y = cvt_pk_bf16(v[2], v[3]); *(u32x2*)(orow + 16 * dt) = wv; } }
    }
}

constexpr int NPH = 14;
__global__ void __launch_bounds__(NWAVES * 64, 2) fwd(Args args) {
    extern __shared__ __attribute__((aligned(16))) unsigned char lds_raw[];
    Frame F; F.lds = (LAS unsigned char*)lds_raw; F.MISC = (volatile LAS unsigned*)(F.lds + MISC_OFF);
    F.tid = threadIdx.x; F.lane = F.tid & 63; F.wave = __builtin_amdgcn_readfirstlane(F.tid >> 6);
    F.G = gridDim.x; { const int bx = blockIdx.x; F.vcu = (F.G % 8 == 0) ? (bx % 8) * (F.G / 8) + bx / 8 : bx; }
    F.ws = args.ws; F.ctl = (gu32*)(args.ws + WS_CTL);
    unsigned char* ws = args.ws;
    for (int u = F.tid; u < (LDS_BYTES - LDSCTL_OFF) / 4; u += NWAVES * 64) ((LAS unsigned*)(F.lds + LDSCTL_OFF))[u] = 0u;
    __syncthreads();
    const int lo = args.ph_lo, hi = args.ph_hi;
    XcdBarrier bar; bar.bar = (unsigned*)(F.ctl + CW_BAR); bar.x = 0; bar.st = nullptr;
    if (hi - lo > 1) bar = xcd_barrier_post((unsigned*)(F.ctl + CW_BAR), F.MISC + 8);
#define IN(k) (lo <= (k) && (k) < hi)
#define SEAM(k) do { if (IN(k) && IN((k) + 1)) xcd_barrier(bar); } while (0)
    const int bx = (int)blockIdx.x;
    unsigned short* XB = (unsigned short*)(ws + WS_XB);
    u64* ss0 = (u64*)(ws + WS_SS0); u64* ssv = (u64*)(ws + WS_SSV); u64* ss1 = (u64*)(ws + WS_SS1); u64* ss2 = (u64*)(ws + WS_SS2);

    if (IN(0)) { p0_prologue(F, args); } SEAM(0);
    if (IN(1)) {
        DenseOrder S{T / BM, DFF / BM, F.G, bx}; EpiGeluZ E{(unsigned short*)(ws + WS_Z), ss0, ssv};
        gemm_phase<EpiGeluZ, DenseOrder, true>(F.lds, (const char*)XB, (const char*)(ws + WS_WIN), D, D * 2, D * 2, S, E);
    } SEAM(1);
    if (IN(2)) { p2_gating(F, args); } SEAM(2);
    if (IN(3)) {
        DenseOrder S{T / BM, D / BM, F.G, bx}; EpiResid E{args.in[0], args.out, XB, ss1};
        gemm_phase<EpiResid, DenseOrder, false>(F.lds, (const char*)(ws + WS_Z), (const char*)(ws + WS_WOUT), HALFC, DFF * 2, HALFC * 2, S, E);
    } SEAM(3);
    if (IN(4)) {
        DenseOrder S{T / BM, 2 * FFN / BM, F.G, bx}; EpiSwiglu E{(unsigned short*)(ws + WS_H), FFN, ss1};
        gemm_phase<EpiSwiglu, DenseOrder, true>(F.lds, (const char*)XB, (const char*)(ws + WS_WGU), D, D * 2, D * 2, S, E);
    } SEAM(4);
    if (IN(5)) {
        DenseOrder S{T / BM, D / BM, F.G, bx}; EpiResid E{args.out, args.out, XB, ss2};
        gemm_phase<EpiResid, DenseOrder, false>(F.lds, (const char*)(ws + WS_H), (const char*)(ws + WS_WD), FFN, FFN * 2, FFN * 2, S, E);
    } SEAM(5);
    if (IN(6)) {
        DenseOrder S{T / BM, 3 * D / BM, F.G, bx}; EpiQKV E{(unsigned short*)(ws + WS_Q), (size_t)(WS_K - WS_Q) / 2, ss2, (args.flags & FL_QSCALE1) ? 1.0f : 0.125f * LOG2E};
        gemm_phase<EpiQKV, DenseOrder, true>(F.lds, (const char*)XB, (const char*)(ws + WS_WQKV), D, D * 2, D * 2, S, E);
    } SEAM(6);
    if (IN(7)) { p7_attention(F, args); } SEAM(7);
    if (IN(8)) {
        DenseOrder S{T / BM, D / BM, F.G, bx}; EpiResid E{args.out, args.out, nullptr, nullptr};
        gemm_phase<EpiResid, DenseOrder, false>(F.lds, (const char*)(ws + WS_O), (const char*)(ws + WS_WO), D, D * 2, D * 2, S, E);
    } SEAM(8);
    if (IN(9)) { p9_router(F, args); } SEAM(9);
    if (IN(10)) { p9b_gather(F, args); } SEAM(10);
    if (IN(11)) {
        MoeOrder S; S.init((const int*)(F.ctl + CW_CNT), 2 * EDIM / BM, F.G, bx, 2 * EDIM); EpiSwiglu E{(unsigned short*)(ws + WS_HM), EDIM, nullptr};
        gemm_phase<EpiSwiglu, MoeOrder, true>(F.lds, (const char*)(ws + WS_XG), (const char*)(ws + WS_WEGU), D, D * 2, D * 2, S, E);
    } SEAM(11);
    if (IN(12)) {
        MoeOrder S; S.init((const int*)(F.ctl + CW_CNT), D / BM, F.G, bx, D); EpiMoe2 E{(unsigned short*)(ws + WS_Y), (const float*)(ws + WS_SLOTW)};
        gemm_phase<EpiMoe2, MoeOrder, true>(F.lds, (const char*)(ws + WS_HM), (const char*)(ws + WS_WED), EDIM, EDIM * 2, EDIM * 2, S, E);
    } SEAM(12);
    if (IN(13)) { p12_final(F, args); }
#undef IN
#undef SEAM
}
}
extern "C" void kernel_launch(void* const* d_in, const int* in_sizes, int n_in, void* d_out, int out_size, void* d_ws, size_t ws_size, hipStream_t stream) {
    static int grid = 0;
    if (grid == 0) {
        if (n_in != 20 || out_size != mk::T * mk::D || ws_size < mk::WS_END) { fprintf(stderr, "kernel_launch: unexpected sizes (ws %zu)\n", ws_size); grid = -1; return; }
        int dev = 0, cus = 0;
        if (hipGetDevice(&dev) != hipSuccess || hipDeviceGetAttribute(&cus, hipDeviceAttributeMultiprocessorCount, dev) != hipSuccess) { grid = -1; return; }
        if (hipFuncSetAttribute((const void*)mk::fwd, hipFuncAttributeMaxDynamicSharedMemorySize, mk::LDS_BYTES) != hipSuccess) { fprintf(stderr, "kernel_launch: hipFuncSetAttribute failed\n"); grid = -1; return; }
        grid = cus;
    }
    if (grid < 0) return;
    unsigned char* ws = (unsigned char*)d_ws;
    (void)hipMemsetAsync(ws + mk::WS_CTL, 0, mk::CTL_ZERO_BYTES, stream);
    mk::Args a; for (int i = 0; i < 20; ++i) a.in[i] = (const float*)d_in[i];
    a.out = (float*)d_out; a.ws = ws; a.flags = mk::FL_L0 | mk::FL_EXPERTS; a.pad = 0;
    a.ph_lo = 0; a.ph_hi = mk::NPH; hipLaunchKernelGGL(mk::fwd, dim3(grid), dim3(512), mk::LDS_BYTES, stream, a);
}
```

```cpp
#include <hip/hip_runtime.h>
#include <cstdint>
#include <cstdio>

typedef unsigned short bf16_t;
#ifndef PROBE_REP
#define PROBE_REP 0xff
#endif
#ifndef PROBE_DRY
#define PROBE_DRY 1
#endif
#ifndef PROBE_TS
#define PROBE_TS 0
#endif
namespace mk {
#define LAS __attribute__((address_space(3)))
#define GAS __attribute__((address_space(1)))
typedef short bf16x8 __attribute__((ext_vector_type(8)));
typedef short s16x4 __attribute__((ext_vector_type(4)));
typedef float f32x4 __attribute__((ext_vector_type(4)));
typedef float f32x2 __attribute__((ext_vector_type(2)));
typedef unsigned u32x4 __attribute__((ext_vector_type(4)));
typedef unsigned u32x2 __attribute__((ext_vector_type(2)));
typedef GAS unsigned gu32;

constexpr int T = 16384, D = 1024, SEQ = 4096, NB = 4;
constexpr int DFF = 6144, HALFC = 3072, GRP = 8, GDIM = 384, GBLK = 128, CHUNK = 64;
constexpr int NH = 16, HD = 64, LEFT = 8, RELSZ = 320, RELCLIP = 256;
constexpr int FFN = 2816, NE = 8, EDIM = 3584;
constexpr int SLOTS = 34816;
constexpr float EPS = 1e-6f;
constexpr float LOG2E = 1.4426950408889634f;

constexpr size_t KiB = 1024, MiB = 1u << 20;
constexpr size_t WS_CTL = 0, CTL_ZERO_BYTES = 1 * MiB;
constexpr size_t WS_SS0 = 128 * KiB, WS_SSV = 256 * KiB, WS_SS1 = 384 * KiB, WS_SS2 = 512 * KiB;
constexpr size_t WS_LIST = 1 * MiB, WS_TOKSLOT = WS_LIST + 512 * KiB, WS_TOKW = WS_TOKSLOT + 256 * KiB, WS_R3 = 2 * MiB, WS_SLOTW = WS_R3 + 256 * KiB, WS_SLOTTOK = WS_LIST + 64 * KiB;
constexpr size_t WS_WEGU = 4 * MiB, WS_WED = 116 * MiB;
constexpr size_t WS_WIN = 172 * MiB, WS_WOUT = 184 * MiB, WS_WGU = 190 * MiB, WS_WD = 201 * MiB, WS_WQKV = 207 * MiB, WS_WO = 213 * MiB;
constexpr size_t WS_XB = 215 * MiB;
constexpr size_t WS_Z = 247 * MiB;
constexpr size_t WS_H = 247 * MiB;
constexpr size_t WS_Q = 247 * MiB, WS_K = 279 * MiB, WS_V = 311 * MiB, WS_O = 343 * MiB;
constexpr size_t WS_X3N = 172 * MiB;
constexpr size_t WS_PART = 172 * MiB; constexpr int PART_CAP = 172;
constexpr size_t WS_HM = 247 * MiB;
constexpr size_t WS_Y = 4 * MiB;
constexpr size_t WS_END = 485 * MiB;
static_assert(WS_HM + (size_t)SLOTS * EDIM * 2 <= WS_END && WS_X3N + (size_t)T * D * 2 <= WS_XB && WS_PART + (size_t)PART_CAP * 262144 <= WS_XB && WS_XB + (size_t)T * D * 2 <= WS_HM && WS_Z + (size_t)T * DFF * 2 <= WS_END && WS_WO + 2 * MiB <= WS_XB, "ws map");
constexpr int CW_TMO = 0, CW_CNT = 64, CW_BAR = 4096;

constexpr int RING_BYTES = 131072, LDSCTL_OFF = 143360, MISC_OFF = LDSCTL_OFF + 320, LDS_BYTES = 147456;
constexpr int NWAVES = 8;

#define RLX_AGENT __ATOMIC_RELAXED, __HIP_MEMORY_SCOPE_AGENT
typedef unsigned long long u64;
constexpr float SS_SCALE = 16777216.0f, SS_INV = 1.0f / 16777216.0f;
__device__ __forceinline__ float rs_of(const u64* ss, int row, float inv_n) { return rsqrtf((float)ss[row] * (SS_INV * inv_n) + 1e-6f); }
__device__ __forceinline__ void ss_add(u64* ss, int row, float q) { __hip_atomic_fetch_add(ss + row, (u64)(q * SS_SCALE), RLX_AGENT); }
#define LDS_WAIT() asm volatile("s_waitcnt lgkmcnt(0)" ::: "memory")
#define VM_WAIT() asm volatile("s_waitcnt vmcnt(0)" ::: "memory")
__device__ __forceinline__ unsigned cvt_pk_bf16(float lo, float hi) { unsigned r; asm volatile("v_cvt_pk_bf16_f32 %0, %1, %2" : "=v"(r) : "v"(lo), "v"(hi)); return r; }
__device__ __forceinline__ float bf2f(unsigned short b) { return __uint_as_float(((unsigned)b) << 16); }
__device__ __forceinline__ float wave_sum(float v) {
#pragma unroll
    for (int o = 1; o < 64; o <<= 1) v += __shfl_xor(v, o);
    return v;
}

#define XB_TMO      128
#define XB_XCNT(j)  (256  + 64 * (j))
#define XB_XSUB(j)  (1280 + 64 * (j))
#define XB_XGEN(j)  (2304 + 64 * (j))
#define XB_TOP      3328
#define XB_TOPGEN   3392
#define XCD_BAR_WORDS 3456
#define XB_SPIN_CAP (1u << 18)
__device__ __forceinline__ unsigned xb_ld(unsigned* p)              { return __hip_atomic_load(p, __ATOMIC_RELAXED, __HIP_MEMORY_SCOPE_AGENT); }
__device__ __forceinline__ unsigned xb_add(unsigned* p, unsigned v) { return __hip_atomic_fetch_add(p, v, __ATOMIC_RELAXED, __HIP_MEMORY_SCOPE_AGENT); }
__device__ __forceinline__ unsigned xb_xcc_id() { return (unsigned)__builtin_amdgcn_s_getreg((3 << 11) | 20) & 0xFu; }
#define XB_SPIN(cond, bar) do { unsigned _sp = 0; while (cond) { __builtin_amdgcn_s_sleep(1); \
    if ((++_sp & 255u) == 0u) { if (xb_ld(&(bar)[XB_TMO])) break; if (_sp > XB_SPIN_CAP) { atomicAdd(&(bar)[XB_TMO], 1u); break; } } } } while (0)
struct XcdBarrier { unsigned* bar; unsigned x; volatile LAS unsigned* st; };
__device__ __forceinline__ XcdBarrier xcd_barrier_post(unsigned* bar, volatile LAS unsigned* st) {
    XcdBarrier b; b.bar = bar; b.x = xb_xcc_id(); b.st = st;
    if (threadIdx.x == 0) (void)xb_add(&bar[XB_XCNT(b.x)], 1u);
    return b;
}
__device__ __forceinline__ void xcd_barrier_complete(unsigned* bar, unsigned x, unsigned& nloc, unsigned& nx) {
    const unsigned G = gridDim.x * gridDim.y * gridDim.z;
    unsigned sum, cnt, mine, sp = 0u;
    for (;;) {
        sum = 0u; cnt = 0u; mine = 0u;
#pragma unroll
        for (unsigned j = 0; j < 16; ++j) { const unsigned c = xb_ld(&bar[XB_XCNT(j)]); sum += c; cnt += (c > 0u) ? 1u : 0u; mine = (j == x) ? c : mine; }
        if (sum == G) break;
        __builtin_amdgcn_s_sleep(1);
        if ((++sp & 255u) == 0u) { if (xb_ld(&bar[XB_TMO])) break; if (sp > XB_SPIN_CAP) { atomicAdd(&bar[XB_TMO], 1u); break; } }
    }
    nloc = mine > 0u ? mine : 1u; nx = cnt > 0u ? cnt : 1u;
}
__device__ __forceinline__ void xcd_barrier(const XcdBarrier& b) {
    asm volatile("s_waitcnt vmcnt(0)" ::: "memory");
    __syncthreads();
    if (threadIdx.x == 0) {
        unsigned* bar = b.bar;
        __builtin_amdgcn_s_waitcnt(0);
        unsigned nloc = b.st[0], nx = b.st[1];
        if (nloc == 0u) { xcd_barrier_complete(bar, b.x, nloc, nx); b.st[0] = nloc; b.st[1] = nx; }
        const unsigned old = xb_add(&bar[XB_XSUB(b.x)], 1u);
        const unsigned gen = old / nloc;
        if (old + 1u == (gen + 1u) * nloc) {
            __builtin_amdgcn_fence(__ATOMIC_RELEASE, "agent");
            asm volatile("s_waitcnt vmcnt(0)" ::: "memory");
            const unsigned og = xb_add(&bar[XB_TOP], 1u);
            const unsigned tg = og / nx;
            if (og + 1u == (tg + 1u) * nx) xb_add(&bar[XB_TOPGEN], 1u);
            else XB_SPIN(xb_ld(&bar[XB_TOPGEN]) == tg, bar);
            __builtin_amdgcn_fence(__ATOMIC_ACQUIRE, "agent");
            xb_add(&bar[XB_XGEN(b.x)], 1u);
            asm volatile("s_waitcnt vmcnt(0)" ::: "memory");
        } else {
            XB_SPIN(xb_ld(&bar[XB_XGEN(b.x)]) == gen, bar);
            __builtin_amdgcn_fence(__ATOMIC_ACQUIRE, "agent");
            asm volatile("s_waitcnt vmcnt(0)" ::: "memory");
        }
    }
    __syncthreads();
}

constexpr int BM = 256, BK = 64, HALF = 128, HTB = HALF * BK * 2, NXCD = 8, WGM = 8;
__device__ __forceinline__ int lds_byte(int r, int c) { const int st = (r >> 4) * 2 + (c >> 5), rr = r & 15, cc = c & 31, ob = rr * 64 + cc * 2; return st * 1024 + (ob ^ (((ob >> 9) & 1) << 5)); }
__device__ __forceinline__ void stage_rc(int b, int& R, int& C) { const int st = b / 1024, sb = b % 1024, swz = sb ^ (((sb >> 9) & 1) << 5); R = (st >> 1) * 16 + swz / 64; C = (st & 1) * 32 + (swz % 64) / 2; }
__device__ __forceinline__ int perm32(int rho) { const int n = rho >> 4, i = rho & 15; return 8 * (i >> 2) + 4 * n + (i & 3); }

struct Unit { int pm, pn, e, rows; int arow, brow; int koff, sub; };

__device__ __forceinline__ void tile_of(int L, int nM, int nN, int& pm, int& pn) {
    const int nwg = nM * nN; int wgid = L;
    { const int q = nwg / NXCD, r = nwg % NXCD, xcd = wgid % NXCD, off = wgid / NXCD; wgid = (xcd < r ? xcd * (q + 1) : r * (q + 1) + (xcd - r) * q) + off; }
    const int nig = WGM * nN, gid = wgid / nig, fm = gid * WGM, gsz = (nM - fm) < WGM ? (nM - fm) : WGM;
    pm = fm + ((wgid % nig) % gsz); pn = (wgid % nig) / gsz;
}
struct DenseOrder {
    int nM, nN, G, c;
    __device__ __forceinline__ bool next(int i, Unit& u) const {
        const long L = (long)i * G + c; if (L >= (long)nM * nN) return false;
        tile_of((int)L, nM, nN, u.pm, u.pn); u.e = 0; u.rows = BM; u.arow = u.pm * BM; u.brow = u.pn * BM; u.koff = 0; u.sub = 0; return true;
    }
};
struct MoeOrder {
    int t1, t2, t3, t4, t5, t6, t7, nM, nN, G, c, bexp; int c0, c1, c2, c3, c4, c5, c6, c7; int Lend, rev;
    __device__ __forceinline__ void init(const int* cnt, int nN_, int G_, int c_, int bexp_) {
        c0 = cnt[0]; c1 = cnt[1]; c2 = cnt[2]; c3 = cnt[3]; c4 = cnt[4]; c5 = cnt[5]; c6 = cnt[6]; c7 = cnt[7];
        t1 = (c0 + 255) >> 8; t2 = t1 + ((c1 + 255) >> 8); t3 = t2 + ((c2 + 255) >> 8); t4 = t3 + ((c3 + 255) >> 8); t5 = t4 + ((c4 + 255) >> 8); t6 = t5 + ((c5 + 255) >> 8); t7 = t6 + ((c6 + 255) >> 8);
        nM = t7 + ((c7 + 255) >> 8); nN = nN_; G = G_; c = c_; bexp = bexp_; Lend = nM * nN; rev = 0;
    }
    __device__ __forceinline__ void fill(int L, Unit& u) const {
        tile_of(L, nM, nN, u.pm, u.pn); if (rev) u.pm = nM - 1 - u.pm;
        const int pm = u.pm; const int e = (pm >= t1) + (pm >= t2) + (pm >= t3) + (pm >= t4) + (pm >= t5) + (pm >= t6) + (pm >= t7);
        const int tb = e == 0 ? 0 : e == 1 ? t1 : e == 2 ? t2 : e == 3 ? t3 : e == 4 ? t4 : e == 5 ? t5 : e == 6 ? t6 : t7;
        const int ce = e == 0 ? c0 : e == 1 ? c1 : e == 2 ? c2 : e == 3 ? c3 : e == 4 ? c4 : e == 5 ? c5 : e == 6 ? c6 : c7;
        const int left = ce - (pm - tb) * BM;
        u.e = e; u.rows = left < BM ? left : BM; u.arow = pm * BM; u.brow = e * bexp + u.pn * BM; u.koff = 0; u.sub = 0;
    }
    __device__ __forceinline__ bool next(int i, Unit& u) const { const long L = (long)i * G + c; if (L >= (long)Lend) return false; fill((int)L, u); return true; }
    __device__ __forceinline__ int arow_of(int i) const { const long L = (long)i * G + c; if (L >= (long)Lend) return -1; int pm, pn; tile_of((int)L, nM, nN, pm, pn); return pm * BM; }
};
struct MoeSplit { MoeOrder base; int L0, R, S, klen;
    __device__ __forceinline__ bool next(int i, Unit& u) const { const long j = (long)i * base.G + base.c; if (j >= (long)R * S) return false;
        base.fill(L0 + (int)(j / S), u); u.koff = (int)(j % S) * klen; u.sub = (int)j; return true; }
};

__device__ __forceinline__ f32x2 gelu_pk(f32x2 v) {
    const f32x2 av = __builtin_elementwise_abs(v), d = av * 0.2316418882f + 1.0f;
    f32x2 t; t.x = __builtin_amdgcn_rcpf(d.x); t.y = __builtin_amdgcn_rcpf(d.y);
    f32x2 q = t * 0.5307027145f + (-0.7265760135f); q = q * t + 0.7107068705f; q = q * t + (-0.142248368f); q = q * t + 0.127414796f; q = q * t;
    const f32x2 s = (v * v) * (-0.72134752044f);
    f32x2 e; e.x = __builtin_amdgcn_exp2f(s.x); e.y = __builtin_amdgcn_exp2f(s.y);
    const f32x2 m = v * (q * e), r = v - m;
    f32x2 o; o.x = v.x < 0.f ? m.x : r.x; o.y = v.y < 0.f ? m.y : r.y; return o;
}
__device__ __forceinline__ f32x2 gelu_poly(f32x2 v) {
    f32x2 vc; vc.x = __builtin_fminf(__builtin_fmaxf(v.x, -4.0f), 4.0f); vc.y = __builtin_fminf(__builtin_fmaxf(v.y, -4.0f), 4.0f);
    const f32x2 tp = (vc * vc) * 0.125f - 1.0f;
    f32x2 p = tp * (-4.910800148e-04f) + 1.554953273e-03f; p = p * tp + (-2.861224474e-03f); p = p * tp + 5.916367646e-03f; p = p * tp + (-1.241304364e-02f); p = p * tp + 2.262065592e-02f;
    p = p * tp + (-3.688757600e-02f); p = p * tp + 5.592306942e-02f; p = p * tp + (-8.432015039e-02f); p = p * tp + 1.759499681e-01f;
    return v * (vc * p + 0.5f);
}
__device__ __forceinline__ float silu_f(float v) { return v * __builtin_amdgcn_rcpf(1.0f + __builtin_amdgcn_exp2f(-LOG2E * v)); }

typedef f32x4 Acc[2][2][4][2];
struct EpiGeluZ { static constexpr bool PERM = true;
    unsigned short* Z; const u64* ss; u64* ssv;
    __device__ __forceinline__ void operator()(const Acc& acc, const Unit& u, int wr, int wc, int fr, int fq) const {
        const int row0 = u.pm * BM + wr * 64 + fr, col0 = u.pn * BM + wc * 32 + 8 * fq; const bool isv = u.pn >= (HALFC / BM);
        float rr[2][4];
#pragma unroll
        for (int ai = 0; ai < 2; ++ai)
#pragma unroll
            for (int m = 0; m < 4; ++m) rr[ai][m] = rs_of(ss, row0 + ai * HALF + m * 16, 1.0f / D);
        asm volatile("" ::: "memory");
#pragma unroll
        for (int ai = 0; ai < 2; ++ai)
#pragma unroll
            for (int m = 0; m < 4; ++m) { const int row = row0 + ai * HALF + m * 16; const float r = rr[ai][m]; float q = 0.f;
                unsigned short* rowp = Z + (size_t)row * DFF + col0;
#pragma unroll
                for (int bj = 0; bj < 2; ++bj) { const f32x4 v0 = acc[ai][bj][m][0] * r, v1 = acc[ai][bj][m][1] * r;
                    const f32x2 a = gelu_poly((f32x2){v0[0], v0[1]}), b = gelu_poly((f32x2){v0[2], v0[3]}), c = gelu_poly((f32x2){v1[0], v1[1]}), d = gelu_poly((f32x2){v1[2], v1[3]});
                    q += (a.x * a.x + a.y * a.y) + (b.x * b.x + b.y * b.y) + (c.x * c.x + c.y * c.y) + (d.x * d.x + d.y * d.y);
                    u32x4 w; w.x = cvt_pk_bf16(a.x, a.y); w.y = cvt_pk_bf16(b.x, b.y); w.z = cvt_pk_bf16(c.x, c.y); w.w = cvt_pk_bf16(d.x, d.y);
                    *(u32x4*)(rowp + bj * HALF) = w; }
                if (isv) { q += __shfl_xor(q, 16); q += __shfl_xor(q, 32); if (fq == 0) ss_add(ssv, row, q); } }
    }
};
template <bool F32IN, bool F32OUT = false> struct EpiResid { static constexpr bool PERM = true;
    const float* xin; unsigned short* XB; u64* ss; float* xout;
    __device__ __forceinline__ void operator()(const Acc& acc, const Unit& u, int wr, int wc, int fr, int fq) const {
        const int row0 = u.pm * BM + wr * 64 + fr, col0 = u.pn * BM + wc * 32 + 8 * fq;
#pragma unroll
        for (int ai = 0; ai < 2; ++ai) {
            f32x4 pre[4][2][2];
#pragma unroll
            for (int m = 0; m < 4; ++m) { const size_t off = (size_t)(row0 + ai * HALF + m * 16) * D + col0;
#pragma unroll
                for (int bj = 0; bj < 2; ++bj) {
                    if (F32IN) { pre[m][bj][0] = *(const f32x4*)(xin + off + bj * HALF); pre[m][bj][1] = *(const f32x4*)(xin + off + bj * HALF + 4); }
                    else { const u32x4 w = *(const u32x4*)(XB + off + bj * HALF);
                        pre[m][bj][0] = (f32x4){__uint_as_float(w.x << 16), __uint_as_float(w.x & 0xffff0000u), __uint_as_float(w.y << 16), __uint_as_float(w.y & 0xffff0000u)};
                        pre[m][bj][1] = (f32x4){__uint_as_float(w.z << 16), __uint_as_float(w.z & 0xffff0000u), __uint_as_float(w.w << 16), __uint_as_float(w.w & 0xffff0000u)}; } } }
            asm volatile("" ::: "memory");
#pragma unroll
            for (int m = 0; m < 4; ++m) { const int row = row0 + ai * HALF + m * 16; const size_t off = (size_t)row * D + col0; float q = 0.f;
#pragma unroll
                for (int bj = 0; bj < 2; ++bj) { const f32x4 o0 = pre[m][bj][0] + acc[ai][bj][m][0], o1 = pre[m][bj][1] + acc[ai][bj][m][1];
                    q += (o0[0] * o0[0] + o0[1] * o0[1]) + (o0[2] * o0[2] + o0[3] * o0[3]) + (o1[0] * o1[0] + o1[1] * o1[1]) + (o1[2] * o1[2] + o1[3] * o1[3]);
                    if (F32OUT) { *(f32x4*)(xout + off + bj * HALF) = o0; *(f32x4*)(xout + off + bj * HALF + 4) = o1; }
                    else { u32x4 w; w.x = cvt_pk_bf16(o0[0], o0[1]); w.y = cvt_pk_bf16(o0[2], o0[3]); w.z = cvt_pk_bf16(o1[0], o1[1]); w.w = cvt_pk_bf16(o1[2], o1[3]);
                        *(u32x4*)(XB + off + bj * HALF) = w; } }
                if (ss) { q += __shfl_xor(q, 16); q += __shfl_xor(q, 32); if (fq == 0) ss_add(ss, row, q); } }
            asm volatile("" ::: "memory");
        }
    }
};
__device__ __forceinline__ unsigned swiglu_pk(f32x2 g, f32x2 u) {
    const f32x2 t = g * (-LOG2E); f32x2 e; e.x = __builtin_amdgcn_exp2f(t.x); e.y = __builtin_amdgcn_exp2f(t.y);
    const f32x2 d = e + 1.0f; f32x2 rc; rc.x = __builtin_amdgcn_rcpf(d.x); rc.y = __builtin_amdgcn_rcpf(d.y);
    const f32x2 o = (g * u) * rc; return cvt_pk_bf16(o.x, o.y);
}
template <bool SCALED> struct EpiSwigluT { static constexpr bool PERM = true;
    unsigned short* H; int ldo; const u64* ss;
    __device__ __forceinline__ void operator()(const Acc& acc, const Unit& u, int wr, int wc, int fr, int fq) const {
        const int row0 = u.pm * BM + wr * 64 + fr, col0 = u.pn * HALF + wc * 32 + 8 * fq, lrow0 = wr * 64 + fr;
        float rr[2][4];
        if constexpr (SCALED) {
#pragma unroll
            for (int ai = 0; ai < 2; ++ai)
#pragma unroll
                for (int m = 0; m < 4; ++m) rr[ai][m] = rs_of(ss, row0 + ai * HALF + m * 16, 1.0f / D);
            asm volatile("" ::: "memory"); }
#pragma unroll
        for (int ai = 0; ai < 2; ++ai)
#pragma unroll
            for (int m = 0; m < 4; ++m) { const int row = row0 + ai * HALF + m * 16;
                f32x4 g0 = acc[ai][0][m][0], g1 = acc[ai][0][m][1], u0 = acc[ai][1][m][0], u1 = acc[ai][1][m][1];
                if constexpr (SCALED) { const float r = rr[ai][m]; g0 = g0 * r; g1 = g1 * r; u0 = u0 * r; u1 = u1 * r; }
                u32x4 w; w.x = swiglu_pk((f32x2){g0[0], g0[1]}, (f32x2){u0[0], u0[1]}); w.y = swiglu_pk((f32x2){g0[2], g0[3]}, (f32x2){u0[2], u0[3]});
                w.z = swiglu_pk((f32x2){g1[0], g1[1]}, (f32x2){u1[0], u1[1]}); w.w = swiglu_pk((f32x2){g1[2], g1[3]}, (f32x2){u1[2], u1[3]});
                if (lrow0 + ai * HALF + m * 16 < u.rows) *(u32x4*)(H + (size_t)row * ldo + col0) = w; }
    }
};
struct EpiQKV { static constexpr bool PERM = true;
    unsigned short* Q; size_t tstride; const u64* ss; float qscale;
    __device__ __forceinline__ void operator()(const Acc& acc, const Unit& u, int wr, int wc, int fr, int fq) const {
        const int t = u.pn >> 2; unsigned short* base = Q + (size_t)t * tstride; const float sc = t == 0 ? qscale : 1.0f;
        const int row0 = u.pm * BM + wr * 64 + fr, col0 = (u.pn & 3) * BM + wc * 32 + 8 * fq;
        float rr[2][4];
#pragma unroll
        for (int ai = 0; ai < 2; ++ai)
#pragma unroll
            for (int m = 0; m < 4; ++m) rr[ai][m] = rs_of(ss, row0 + ai * HALF + m * 16, 1.0f / D) * sc;
        asm volatile("" ::: "memory");
#pragma unroll
        for (int ai = 0; ai < 2; ++ai)
#pragma unroll
            for (int m = 0; m < 4; ++m) { const int row = row0 + ai * HALF + m * 16; const float r = rr[ai][m];
                unsigned short* rowp = base + (size_t)row * D + col0;
#pragma unroll
                for (int bj = 0; bj < 2; ++bj) { const f32x4 v0 = acc[ai][bj][m][0] * r, v1 = acc[ai][bj][m][1] * r;
                    u32x4 w; w.x = cvt_pk_bf16(v0[0], v0[1]); w.y = cvt_pk_bf16(v0[2], v0[3]); w.z = cvt_pk_bf16(v1[0], v1[1]); w.w = cvt_pk_bf16(v1[2], v1[3]);
                    *(u32x4*)(rowp + bj * HALF) = w; } }
    }
};
struct EpiMoe2 { static constexpr bool PERM = true;
    unsigned short* Y; const float* slotw;
    __device__ __forceinline__ void operator()(const Acc& acc, const Unit& u, int wr, int wc, int fr, int fq) const {
        const int row0 = u.pm * BM + wr * 64 + fr, col0 = u.pn * BM + wc * 32 + 8 * fq, lrow0 = wr * 64 + fr;
        float rr[2][4];
#pragma unroll
        for (int ai = 0; ai < 2; ++ai)
#pragma unroll
            for (int m = 0; m < 4; ++m) rr[ai][m] = (lrow0 + ai * HALF + m * 16 < u.rows) ? slotw[row0 + ai * HALF + m * 16] : 0.f;
        asm volatile("" ::: "memory");
#pragma unroll
        for (int ai = 0; ai < 2; ++ai)
#pragma unroll
            for (int m = 0; m < 4; ++m) { const int row = row0 + ai * HALF + m * 16; const bool ok = lrow0 + ai * HALF + m * 16 < u.rows; const float r = rr[ai][m];
                unsigned short* rowp = Y + (size_t)row * D + col0;
#pragma unroll
                for (int bj = 0; bj < 2; ++bj) { const f32x4 v0 = acc[ai][bj][m][0] * r, v1 = acc[ai][bj][m][1] * r;
                    u32x4 w; w.x = cvt_pk_bf16(v0[0], v0[1]); w.y = cvt_pk_bf16(v0[2], v0[3]); w.z = cvt_pk_bf16(v1[0], v1[1]); w.w = cvt_pk_bf16(v1[2], v1[3]);
                    if (ok) *(u32x4*)(rowp + bj * HALF) = w; } }
    }
};

struct EpiPartial { static constexpr bool PERM = true;
    f32x4* P;
    __device__ __forceinline__ void operator()(const Acc& acc, const Unit& u, int wr, int wc, int fr, int fq) const {
        f32x4* p = P + (size_t)u.sub * 16384 + threadIdx.x;
#pragma unroll
        for (int ai = 0; ai < 2; ++ai)
#pragma unroll
            for (int bj = 0; bj < 2; ++bj)
#pragma unroll
                for (int m = 0; m < 4; ++m)
#pragma unroll
                    for (int n = 0; n < 2; ++n) p[(((ai * 2 + bj) * 4 + m) * 2 + n) * 512] = acc[ai][bj][m][n];
    }
};
template <class Epi, class Sched, bool ALIGN_EPI, bool GATHER = false>
__device__ __forceinline__ void gemm_phase(LAS unsigned char* lds, const char* Abase, const char* Bbase, int K, int lda, int ldb, const Sched& S, const Epi& E, int dry = 0, const int* rowmap = nullptr) {
    const int tid = threadIdx.x, wid = __builtin_amdgcn_readfirstlane(tid >> 6), lane = tid & 63, wr = wid >> 2, wc = wid & 3, fr = lane & 15, fq = lane >> 4;
    const int nt = K / BK;
    unsigned voffA[2], voffB[2]; int gR[2], gC[2];
#pragma unroll
    for (int i = 0; i < 2; ++i) { int R, C; stage_rc(tid * 16 + i * 8192, R, C); const int Rb = Epi::PERM ? ((R & ~31) + perm32(R & 31)) : R;
        voffA[i] = (unsigned)(R * lda + C * 2); voffB[i] = (unsigned)(Rb * ldb + C * 2); gR[i] = R; gC[i] = C * 2; }
    unsigned goff[2][2], gnx[2][2];
    LAS unsigned short* tokl = (LAS unsigned short*)(lds + 131072);
    if constexpr (GATHER) {
        for (int i = 0; i < 16; ++i) { const int ar = S.arow_of(i); if (ar < 0) break; if (tid < BM) tokl[i * BM + tid] = (unsigned short)rowmap[ar + tid]; }
        asm volatile("s_waitcnt vmcnt(0) lgkmcnt(0)" ::: "memory"); __syncthreads();
#pragma unroll
        for (int h = 0; h < 2; ++h)
#pragma unroll
            for (int i = 0; i < 2; ++i) { goff[h][i] = (unsigned)tokl[h * HALF + gR[i]] * (unsigned)lda + (unsigned)gC[i]; gnx[h][i] = goff[h][i]; }
    }
    const size_t kstep = (size_t)(BK * 2);
    const size_t hstepA = (size_t)HALF * lda, hstepB = (size_t)HALF * ldb;
    const unsigned ldsw = (unsigned)wid * 1024u;
    const int aoff = lds_byte(wr * 64 + fr, fq * 8), boff = lds_byte(wc * 32 + fr, fq * 8);
#define PG8_SA(b, h) (((b) * 2 + (h)) * HTB)
#define PG8_SB(b, h) ((4 + (b) * 2 + (h)) * HTB)
#define PG8_STAGE(bufoff, gbase, voff) do { _Pragma("unroll") for (int _i = 0; _i < 2; ++_i) \
        __builtin_amdgcn_global_load_lds((const unsigned*)((const char*)(gbase) + (voff)[_i]), (LAS unsigned*)(lds + (bufoff) + ldsw + _i * 8192), 16, 0, 0); } while (0)
#define PG8_STAGE_A(bufoff, gbase, h) do { if constexpr (GATHER) PG8_STAGE(bufoff, gbase, goff[h]); else PG8_STAGE(bufoff, (gbase) + (h) * hstepA, voffA); } while (0)
#define PG8_LDA(dst, b, h) do { _Pragma("unroll") for (int m = 0; m < 4; ++m) _Pragma("unroll") for (int k = 0; k < 2; ++k) dst[m][k] = *(const LAS bf16x8*)(lds + PG8_SA(b, h) + aoff + m * 2048 + k * 1024); } while (0)
#define PG8_LDB(dst, b, h) do { _Pragma("unroll") for (int n = 0; n < 2; ++n) _Pragma("unroll") for (int k = 0; k < 2; ++k) dst[n][k] = *(const LAS bf16x8*)(lds + PG8_SB(b, h) + boff + n * 2048 + k * 1024); } while (0)
#define PG8_MMA(ai, bj, At, Bt) do { __builtin_amdgcn_s_setprio(1); _Pragma("unroll") for (int m = 0; m < 4; ++m) _Pragma("unroll") for (int n = 0; n < 2; ++n) _Pragma("unroll") for (int k = 0; k < 2; ++k) \
        acc[ai][bj][m][n] = __builtin_amdgcn_mfma_f32_16x16x32_bf16(Bt[n][k], At[m][k], acc[ai][bj][m][n], 0, 0, 0); __builtin_amdgcn_s_setprio(0); } while (0)
#define PG8_WAIT_V(n) asm volatile("s_waitcnt vmcnt(" #n ")" ::: "memory")
#define PG8_WAIT_L(n) asm volatile("s_waitcnt lgkmcnt(" #n ")" ::: "memory")
#define PG8_BAR __builtin_amdgcn_s_barrier()
#define PG8_SCHED __builtin_amdgcn_sched_barrier(0)
    Unit cur, nxt; int ui = 0;
    if (!S.next(0, cur)) return;
    Acc acc;
#pragma unroll
    for (int a = 0; a < 2; ++a)
#pragma unroll
        for (int b = 0; b < 2; ++b)
#pragma unroll
            for (int m = 0; m < 4; ++m)
#pragma unroll
                for (int n = 0; n < 2; ++n) acc[a][b][m][n] = (f32x4){0.f, 0.f, 0.f, 0.f};
    bf16x8 At[4][2], B0[2][2], B1[2][2];
    const char* cA = Abase + (GATHER ? (size_t)0 : (size_t)cur.arow * lda) + cur.koff; const char* cB = Bbase + (size_t)cur.brow * ldb + cur.koff;
    PG8_STAGE(PG8_SB(0, 0), cB, voffB); PG8_STAGE(PG8_SB(0, 1), cB + hstepB, voffB); PG8_STAGE_A(PG8_SA(0, 0), cA, 0); PG8_STAGE_A(PG8_SA(0, 1), cA, 1);
    if (wr == 1) PG8_BAR;
    PG8_WAIT_V(2); PG8_BAR;
    PG8_STAGE(PG8_SB(1, 0), cB + kstep, voffB); PG8_STAGE_A(PG8_SA(1, 0), cA + kstep, 0); PG8_STAGE(PG8_SB(1, 1), cB + hstepB + kstep, voffB);
    PG8_WAIT_V(6); PG8_BAR;
    for (;;) {
        const bool has_next = S.next(ui + 1, nxt);
        const char* nA = has_next ? Abase + (GATHER ? (size_t)0 : (size_t)nxt.arow * lda) + nxt.koff : cA; const char* nB = has_next ? Bbase + (size_t)nxt.brow * ldb + nxt.koff : cB;
        if constexpr (GATHER) { if (has_next) {
#pragma unroll
            for (int h = 0; h < 2; ++h)
#pragma unroll
                for (int i = 0; i < 2; ++i) gnx[h][i] = (unsigned)tokl[(ui + 1) * BM + h * HALF + gR[i]] * (unsigned)lda + (unsigned)gC[i]; } }
        for (int t = 0; t < nt; t += 2) {
            const bool last = (t == nt - 2);
            const char* a1 = cA + (size_t)(t + 1) * kstep;
            const char* a2 = last ? nA : cA + (size_t)(t + 2) * kstep; const char* b2 = last ? nB : cB + (size_t)(t + 2) * kstep;
            const char* a3 = a2 + kstep; const char* b3 = b2 + kstep;
            PG8_LDB(B0, 0, 0); PG8_LDB(B1, 0, 1); PG8_SCHED; PG8_LDA(At, 0, 0); PG8_STAGE_A(PG8_SA(1, 1), a1, 1);
            if constexpr (GATHER) { if (last) { goff[0][0] = gnx[0][0]; goff[0][1] = gnx[0][1]; goff[1][0] = gnx[1][0]; goff[1][1] = gnx[1][1]; } }
            PG8_WAIT_V(8); PG8_WAIT_L(0); PG8_BAR; PG8_MMA(0, 0, At, B0); PG8_MMA(0, 1, At, B1); PG8_BAR; PG8_SCHED;
            PG8_LDA(At, 0, 1); PG8_STAGE(PG8_SB(0, 0), b2, voffB); PG8_STAGE(PG8_SB(0, 1), b2 + hstepB, voffB); PG8_STAGE_A(PG8_SA(0, 0), a2, 0);
            PG8_WAIT_V(8); PG8_WAIT_L(0); PG8_BAR; PG8_MMA(1, 0, At, B0); PG8_MMA(1, 1, At, B1); PG8_BAR; PG8_SCHED;
            PG8_LDB(B0, 1, 0); PG8_LDB(B1, 1, 1); PG8_SCHED; PG8_LDA(At, 1, 0); PG8_STAGE_A(PG8_SA(0, 1), a2, 1);
            PG8_WAIT_V(8); PG8_WAIT_L(0); PG8_BAR; PG8_MMA(0, 0, At, B0); PG8_MMA(0, 1, At, B1); PG8_BAR; PG8_SCHED;
            PG8_LDA(At, 1, 1); PG8_STAGE(PG8_SB(1, 0), b3, voffB); PG8_STAGE(PG8_SB(1, 1), b3 + hstepB, voffB); PG8_STAGE_A(PG8_SA(1, 0), a3, 0);
            PG8_WAIT_V(8); PG8_WAIT_L(0); PG8_BAR; PG8_MMA(1, 0, At, B0); PG8_MMA(1, 1, At, B1); PG8_BAR; PG8_SCHED;
        }
        if constexpr (ALIGN_EPI) { if (wr == 0) PG8_BAR; }
        if (!dry) E(acc, cur, wr, wc, fr, fq);
        if (!has_next) break;
#pragma unroll
        for (int a = 0; a < 2; ++a)
#pragma unroll
            for (int b = 0; b < 2; ++b)
#pragma unroll
                for (int m = 0; m < 4; ++m)
#pragma unroll
                    for (int n = 0; n < 2; ++n) acc[a][b][m][n] = (f32x4){0.f, 0.f, 0.f, 0.f};
        cur = nxt; cA = nA; cB = nB; ++ui;
        if constexpr (ALIGN_EPI) { if (wr == 1) PG8_BAR; }
    }
    PG8_WAIT_V(0);
    if constexpr (!ALIGN_EPI) { if (wr == 0) PG8_BAR; }
    PG8_BAR;
#undef PG8_SA
#undef PG8_SB
#undef PG8_STAGE
#undef PG8_LDA
#undef PG8_STAGE_A
#undef PG8_LDB
#undef PG8_MMA
#undef PG8_WAIT_V
#undef PG8_WAIT_L
#undef PG8_BAR
#undef PG8_SCHED
}

struct Args {
    const float* in[20]; float* out; unsigned char* ws; int ph_lo, ph_hi; int flags, pad;
};
struct Frame {
    LAS unsigned char* lds; volatile LAS unsigned* MISC; unsigned char* ws; gu32* ctl;
    int tid, lane, wave, vcu, G, dry;
};

template <bool NTS = false> __device__ __forceinline__ void tr_item(const float* W, int N, int k0, int n0, unsigned short* WT, int ldt, int row0, const float* gain, LAS float* scr, int lane) {
    const int r = lane >> 5, c2 = lane & 31;
    f32x2 tv[32];
    const float* wp = W + (size_t)(k0 + r) * N + n0 + 2 * c2;
#pragma unroll
    for (int i = 0; i < 32; ++i) tv[i] = __builtin_nontemporal_load((const f32x2*)(wp + (size_t)(2 * i) * N));
    if (gain) {
#pragma unroll
        for (int i = 0; i < 32; ++i) tv[i] = tv[i] * gain[k0 + 2 * i + r]; }
#pragma unroll
    for (int i = 0; i < 32; ++i) { const int kk = 2 * i + r; scr[kk * 65 + 2 * c2] = tv[i].x; scr[kk * 65 + 2 * c2 + 1] = tv[i].y; }
    LDS_WAIT(); asm volatile("" ::: "memory");
    const int c = lane & 7;
#pragma unroll
    for (int j = 0; j < 8; ++j) { const int n = (lane >> 3) + 8 * j; const LAS float* s = scr + (8 * c) * 65 + n;
        u32x4 o; o.x = cvt_pk_bf16(s[0 * 65], s[1 * 65]); o.y = cvt_pk_bf16(s[2 * 65], s[3 * 65]); o.z = cvt_pk_bf16(s[4 * 65], s[5 * 65]); o.w = cvt_pk_bf16(s[6 * 65], s[7 * 65]);
        if (NTS) __builtin_nontemporal_store(o, (u32x4*)(WT + (size_t)(row0 + n) * ldt + k0 + 8 * c)); else *(u32x4*)(WT + (size_t)(row0 + n) * ldt + k0 + 8 * c) = o; }
    LDS_WAIT(); asm volatile("" ::: "memory");
}
template <bool NTS = false> __device__ __forceinline__ void tr_plain(const float* W, int K, int N, unsigned short* WT, const float* gain, LAS float* scr, int item, int lane) {
    const int nblk = N / 64, kb = item / nblk, nb = item % nblk; tr_item<NTS>(W, N, kb * 64, nb * 64, WT, K, nb * 64, gain, scr, lane);
}
template <bool NTS = false> __device__ __forceinline__ void tr_inter(const float* W, int K, int N, unsigned short* WT, int up, const float* gain, LAS float* scr, int item, int lane) {
    const int nblk = N / 64, kb = item / nblk, nb = item % nblk, n0 = nb * 64; tr_item<NTS>(W, N, kb * 64, n0, WT, K, 256 * (n0 >> 7) + (n0 & 127) + up * 128, gain, scr, lane);
}
__device__ __forceinline__ void xb_row(const float* xrow, unsigned short* orow, u64* ssp, int lane) {
    const f32x4* xr = (const f32x4*)xrow + lane; f32x4 v[4]; float s = 0.f;
#pragma unroll
    for (int j = 0; j < 4; ++j) { v[j] = __builtin_nontemporal_load(xr + 64 * j); s += (v[j].x * v[j].x + v[j].y * v[j].y) + (v[j].z * v[j].z + v[j].w * v[j].w); }
    s = wave_sum(s);
    u32x2* o8 = (u32x2*)orow + lane;
#pragma unroll
    for (int j = 0; j < 4; ++j) { u32x2 w; w.x = cvt_pk_bf16(v[j].x, v[j].y); w.y = cvt_pk_bf16(v[j].z, v[j].w); o8[64 * j] = w; }
    if (lane == 0) *ssp = (u64)(s * SS_SCALE);
}

constexpr int FL_EXPERTS = 1, FL_L0 = 2, FL_QSCALE1 = 4;

__device__ __forceinline__ void p0_prologue(Frame& F, const Args& a) {
    LAS float* scr = (LAS float*)(F.lds + F.wave * 16640);
    const int gw = F.vcu * NWAVES + F.wave, NGW = F.G * NWAVES;
    constexpr int I_IN = 16 * 96, I_OUT = 48 * 16, I_G = 16 * 44, I_D = 44 * 16, I_QKV = 16 * 48, I_O = 16 * 16, I_EG = 16 * 56, I_ED = 56 * 16;
    unsigned char* ws = F.ws;
    if (a.flags & FL_EXPERTS) {
        constexpr int NIT = NE * 2 * I_EG;
        for (int it = gw; it < NIT; it += NGW) {
            const int e = it / (2 * I_EG); int r = it % (2 * I_EG);
            if (r < I_EG) { tr_inter<true>(a.in[17] + (size_t)e * D * EDIM, D, EDIM, (unsigned short*)(ws + WS_WEGU) + (size_t)e * 2 * EDIM * D, 0, nullptr, scr, r, F.lane); continue; } r -= I_EG;
            tr_inter<true>(a.in[18] + (size_t)e * D * EDIM, D, EDIM, (unsigned short*)(ws + WS_WEGU) + (size_t)e * 2 * EDIM * D, 1, nullptr, scr, r, F.lane);
        }
    }
    if (a.flags & FL_L0) {
        constexpr int NIT = I_IN + I_OUT + 2 * I_G + I_D + I_QKV + I_O;
        for (int it = gw; it < NIT; it += NGW) {
            int r = NIT - 1 - it;
            if (r < I_IN) { tr_plain(a.in[4], D, DFF, (unsigned short*)(ws + WS_WIN), a.in[1], scr, r, F.lane); continue; } r -= I_IN;
            if (r < I_OUT) { tr_plain(a.in[8], HALFC, D, (unsigned short*)(ws + WS_WOUT), nullptr, scr, r, F.lane); continue; } r -= I_OUT;
            if (r < I_G) { tr_inter(a.in[9], D, FFN, (unsigned short*)(ws + WS_WGU), 0, a.in[2], scr, r, F.lane); continue; } r -= I_G;
            if (r < I_G) { tr_inter(a.in[10], D, FFN, (unsigned short*)(ws + WS_WGU), 1, a.in[2], scr, r, F.lane); continue; } r -= I_G;
            if (r < I_D) { tr_plain(a.in[11], FFN, D, (unsigned short*)(ws + WS_WD), nullptr, scr, r, F.lane); continue; } r -= I_D;
            if (r < I_QKV) { tr_plain(a.in[12], D, 3 * D, (unsigned short*)(ws + WS_WQKV), a.in[1] + D, scr, r, F.lane); continue; } r -= I_QKV;
            tr_plain(a.in[14], D, D, (unsigned short*)(ws + WS_WO), nullptr, scr, r, F.lane);
        }
        for (int m = gw; m < T; m += NGW) xb_row(a.in[0] + (size_t)m * D, (unsigned short*)(ws + WS_XB) + (size_t)m * D, (u64*)(ws + WS_SS0) + m, F.lane);
    }
}
__device__ __forceinline__ void side_convert_wed(Frame& F, const Args& a, int k, int n) {
    LAS float* scr = (LAS float*)(F.lds + F.wave * 16640);
    constexpr int I_ED = 56 * 16, NIT = NE * I_ED;
    for (int it = k * NWAVES + F.wave; it < NIT; it += n * NWAVES) { const int e = it / I_ED, r = it % I_ED;
        tr_plain<true>(a.in[19] + (size_t)e * EDIM * D, EDIM, D, (unsigned short*)(F.ws + WS_WED) + (size_t)e * D * EDIM, nullptr, scr, r, F.lane); }
}

__device__ __forceinline__ void p9_router(Frame& F, const Args& a) {
    LAS float* rwT = (LAS float*)F.lds;
    LAS int* lcnt = (LAS int*)(F.lds + 32768);
    const float* g = a.in[2] + D;
    { const float* rw = a.in[15];
      for (int i = F.tid; i < D * NE; i += NWAVES * 64) { const int k = i >> 3, e = i & 7; rwT[e * D + k] = rw[i] * g[k]; } }
    if (F.tid < NE) lcnt[F.tid] = 0;
    f32x4 gv[4];
#pragma unroll
    for (int j = 0; j < 4; ++j) gv[j] = ((const f32x4*)g)[F.lane + 64 * j];
    LDS_WAIT(); __syncthreads();
    const float* rb = a.in[16]; const unsigned short* XB = (const unsigned short*)(F.ws + WS_XB); unsigned short* X3N = (unsigned short*)(F.ws + WS_X3N);
    int* wgcnt = (int*)(F.ws + WS_LIST); int* tokslot = (int*)(F.ws + WS_TOKSLOT); float* tokw = (float*)(F.ws + WS_TOKW);
    const int TPW = T / F.G, t0 = F.vcu * TPW;
    for (int t = t0 + F.wave; t < t0 + TPW; t += NWAVES) {
        const u32x2* xr = (const u32x2*)(XB + (size_t)t * D) + F.lane; float lg[NE]; float s = 0.f; f32x4 xv[4];
#pragma unroll
        for (int e = 0; e < NE; ++e) lg[e] = 0.f;
#pragma unroll
        for (int j = 0; j < 4; ++j) { const u32x2 w = xr[64 * j]; const f32x4 x = (f32x4){__uint_as_float(w.x << 16), __uint_as_float(w.x & 0xffff0000u), __uint_as_float(w.y << 16), __uint_as_float(w.y & 0xffff0000u)};
            xv[j] = x; s += (x.x * x.x + x.y * x.y) + (x.z * x.z + x.w * x.w);
#pragma unroll
            for (int e = 0; e < NE; ++e) { const f32x4 wv = *(const LAS f32x4*)(rwT + e * D + 4 * (F.lane + 64 * j)); lg[e] += (x.x * wv.x + x.y * wv.y) + (x.z * wv.z + x.w * wv.w); } }
        s = wave_sum(s); const float r = rsqrtf(s * (1.0f / D) + EPS);
        if (!F.dry) { u32x2* o = (u32x2*)(X3N + (size_t)t * D) + F.lane;
#pragma unroll
            for (int j = 0; j < 4; ++j) { const f32x4 v = xv[j] * gv[j] * r; u32x2 w; w.x = cvt_pk_bf16(v.x, v.y); w.y = cvt_pk_bf16(v.z, v.w); o[64 * j] = w; } }
#pragma unroll
        for (int e = 0; e < NE; ++e) lg[e] = wave_sum(lg[e]) * r + rb[e];
        if (F.lane == 0 && !F.dry) {
            int e1 = 0; float v1 = lg[0];
#pragma unroll
            for (int e = 1; e < NE; ++e) if (lg[e] > v1) { v1 = lg[e]; e1 = e; }
            int e2 = -1; float v2 = -3.0e38f;
#pragma unroll
            for (int e = 0; e < NE; ++e) if (e != e1 && lg[e] > v2) { v2 = lg[e]; e2 = e; }
            const float w2 = 1.0f / (1.0f + __expf(v1 - v2)), w1 = 1.0f - w2;
            const int p1 = __hip_atomic_fetch_add(lcnt + e1, 1, __ATOMIC_RELAXED, __HIP_MEMORY_SCOPE_WORKGROUP), p2 = __hip_atomic_fetch_add(lcnt + e2, 1, __ATOMIC_RELAXED, __HIP_MEMORY_SCOPE_WORKGROUP);
            tokslot[t * 4 + 0] = e1; tokslot[t * 4 + 1] = p1; tokslot[t * 4 + 2] = e2; tokslot[t * 4 + 3] = p2;
            tokw[t * 2 + 0] = w1; tokw[t * 2 + 1] = w2;
        }
    }
    LDS_WAIT(); __syncthreads();
    if (F.tid < NE && !F.dry) wgcnt[F.vcu * NE + F.tid] = lcnt[F.tid];
}
__device__ __forceinline__ int slot_base(const int* cnt, int e) {
    int o = 0;
#pragma unroll
    for (int j = 0; j < NE; ++j) { const int c = ((cnt[j] + 255) >> 8) << 8; o += (j < e) ? c : 0; }
    return o;
}
__device__ __forceinline__ void p9b_gather(Frame& F, const Args& a) {
    int* cnt = (int*)(F.ctl + CW_CNT); const int* wgcnt = (const int*)(F.ws + WS_LIST); int* tokslot = (int*)(F.ws + WS_TOKSLOT); const float* tokw = (const float*)(F.ws + WS_TOKW);
    float* slotw = (float*)(F.ws + WS_SLOTW); int* slot_tok = (int*)(F.ws + WS_SLOTTOK);
    LAS int* tot = (LAS int*)F.lds; LAS int* mine = tot + NE; LAS int* sbase = mine + NE; LAS int* gb = sbase + NE;
    __syncthreads();
    {
        const int e = F.wave; int v[4]; int before = 0, total = 0;
#pragma unroll
        for (int j = 0; j < 4; ++j) { const int w = 4 * F.lane + j; v[j] = w < F.G ? wgcnt[w * NE + e] : 0; }
        int mysum = v[0] + v[1] + v[2] + v[3];
        int incl = mysum;
#pragma unroll
        for (int o = 1; o < 64; o <<= 1) { const int n = __shfl_up(incl, o); if (F.lane >= o) incl += n; }
        total = __shfl(incl, 63);
        const int wl = F.vcu >> 2, wj = F.vcu & 3;
        int excl = incl - mysum; int part = excl + (wj > 0 ? v[0] : 0) + (wj > 1 ? v[1] : 0) + (wj > 2 ? v[2] : 0);
        before = __shfl(part, wl);
        if (F.lane == 0) { tot[e] = total; mine[e] = before; }
    }
    LDS_WAIT(); __syncthreads();
    if (F.tid < NE) { int o = 0;
#pragma unroll
        for (int j = 0; j < NE; ++j) { const int c = ((tot[j] + 255) >> 8) << 8; o += (j < F.tid) ? c : 0; }
        sbase[F.tid] = o + mine[F.tid]; gb[F.tid] = o;
        if (blockIdx.x == 0 && !F.dry) cnt[F.tid] = tot[F.tid]; }
    LDS_WAIT(); __syncthreads();
    if (blockIdx.x == 0 && !F.dry) {
#pragma unroll
        for (int e = 0; e < NE; ++e) { const int te = tot[e], n = (((te + 255) >> 8) << 8) - te; if (F.tid < n) { slot_tok[gb[e] + te + F.tid] = 0; slotw[gb[e] + te + F.tid] = 0.f; } } }
    const int TPW = T / F.G, t0 = F.vcu * TPW;
    for (int t = t0 + F.tid; t < t0 + TPW; t += NWAVES * 64) {
        const int e1 = tokslot[t * 4], p1 = tokslot[t * 4 + 1], e2 = tokslot[t * 4 + 2], p2 = tokslot[t * 4 + 3];
        const int s1 = sbase[e1] + p1, s2 = sbase[e2] + p2;
        if (!F.dry) { slot_tok[s1] = t; slot_tok[s2] = t; slotw[s1] = tokw[t * 2]; slotw[s2] = tokw[t * 2 + 1]; tokslot[t * 4 + 1] = s1; tokslot[t * 4 + 3] = s2; }
    }
}
__device__ __forceinline__ void p12_final(Frame& F, const Args& a) {
    const int* cnt = (const int*)(F.ctl + CW_CNT); const int* tokslot = (const int*)(F.ws + WS_TOKSLOT); const unsigned short* Y = (const unsigned short*)(F.ws + WS_Y);
    const f32x4* gr = (const f32x4*)a.in[3] + F.lane;
    const int gw = F.vcu * NWAVES + F.wave, NGW = F.G * NWAVES;
    for (int t = gw; t < T; t += NGW) {
        const size_t s1 = (size_t)tokslot[t * 4 + 1], s2 = (size_t)tokslot[t * 4 + 3];
        f32x4* xr = (f32x4*)(a.out + (size_t)t * D) + F.lane; const u32x2* xb = (const u32x2*)((const unsigned short*)(F.ws + WS_XB) + (size_t)t * D) + F.lane; const u32x2* y1 = (const u32x2*)(Y + s1 * D) + F.lane; const u32x2* y2 = (const u32x2*)(Y + s2 * D) + F.lane;
        f32x4 v[4]; float s = 0.f;
#pragma unroll
        for (int j = 0; j < 4; ++j) { const u32x2 a1 = y1[64 * j], a2 = y2[64 * j], xw = xb[64 * j]; f32x4 x = (f32x4){__uint_as_float(xw.x << 16), __uint_as_float(xw.x & 0xffff0000u), __uint_as_float(xw.y << 16), __uint_as_float(xw.y & 0xffff0000u)};
            x.x += __uint_as_float(a1.x << 16) + __uint_as_float(a2.x << 16); x.y += __uint_as_float(a1.x & 0xffff0000u) + __uint_as_float(a2.x & 0xffff0000u);
            x.z += __uint_as_float(a1.y << 16) + __uint_as_float(a2.y << 16); x.w += __uint_as_float(a1.y & 0xffff0000u) + __uint_as_float(a2.y & 0xffff0000u);
            v[j] = x; s += (x.x * x.x + x.y * x.y) + (x.z * x.z + x.w * x.w); }
        const float r = rsqrtf(wave_sum(s) * (1.0f / D) + EPS);
#pragma unroll
        for (int j = 0; j < 4; ++j) if (!F.dry) xr[64 * j] = v[j] * gr[64 * j] * r;
    }
}


typedef short v4i16_t __attribute__((ext_vector_type(4)));
__device__ __forceinline__ s16x4 lds_tr(LAS unsigned char* p) { return __builtin_bit_cast(s16x4, __builtin_amdgcn_ds_read_tr16_b64_v4i16((LAS v4i16_t*)p)); }
__device__ __forceinline__ void p2_gating(Frame& F, const Args& a) {
    constexpr int VS = 832, WSP = 272;
    LAS unsigned char* Vl = F.lds; LAS unsigned char* Wl = F.lds + 128 * VS; LAS float* rsl = (LAS float*)(F.lds + 128 * VS + 128 * WSP);
    unsigned short* Z = (unsigned short*)(F.ws + WS_Z); const u64* ssv = (const u64*)(F.ws + WS_SSV);
    const float* gain = a.in[5]; const float* wsp = a.in[6]; const float* bsp = a.in[7];
    const int tid = F.tid, lane = F.lane, wave = F.wave, th = wave >> 2, wc = wave & 3, fr = lane & 15, fq = lane >> 4;
    constexpr int NU = (T / GBLK) * GRP;
    const int per = (NU % F.G == 0) ? NU / F.G : 0;
    const int nun = per ? per : (NU - F.vcu + F.G - 1) / F.G;
#define P2_UNIT(i) (per ? F.vcu * per + (i) : (i) * F.G + F.vcu)
    u32x4 vr[12]; float rsv = 0.f;
#define P2_LOADV(un) do { const int blk_ = (un) >> 3, g_ = (un) & 7; _Pragma("unroll") for (int j = 0; j < 12; ++j) { const int id = tid + 512 * j, row = id / 48, ch = id % 48; \
        vr[j] = __builtin_nontemporal_load((const u32x4*)(Z + (size_t)(blk_ * GBLK + row) * DFF + HALFC + g_ * GDIM + ch * 8)); } if (tid < GBLK) rsv = rs_of(ssv, blk_ * GBLK + tid, 1.0f / HALFC); } while (0)
    if (nun <= 0) return;
    P2_LOADV(P2_UNIT(0));
    for (int i = 0; i < nun; ++i) {
        const int un = P2_UNIT(i), blk = un >> 3, g = un & 7; const bool more = i + 1 < nun;
        const int cb = g * GDIM + wc * 96 + 8 * fq;
        u32x4 uu[3][4]; float bb[4];
#pragma unroll
        for (int m = 0; m < 4; ++m) { const int t = 64 * th + 16 * m + fr; bb[m] = bsp[g * GBLK + t];
#pragma unroll
            for (int p = 0; p < 3; ++p) uu[p][m] = __builtin_nontemporal_load((const u32x4*)(Z + (size_t)(blk * GBLK + t) * DFF + cb + 32 * p)); }
#pragma unroll
        for (int j = 0; j < 12; ++j) { const int id = tid + 512 * j, row = id / 48, ch = id % 48; *(LAS u32x4*)(Vl + row * VS + ch * 16) = vr[j]; }
        if (tid < GBLK) rsl[tid] = rsv;
        LDS_WAIT(); __syncthreads();
        { const int t = tid >> 2, s0 = (tid & 3) * 32; const f32x4* wrow = (const f32x4*)(wsp + ((size_t)g * GBLK + t) * GBLK + s0);
#pragma unroll
            for (int j = 0; j < 4; ++j) { const f32x4 w0 = wrow[2 * j], w1 = wrow[2 * j + 1]; const f32x4 r0 = *(const LAS f32x4*)(rsl + s0 + 8 * j), r1 = *(const LAS f32x4*)(rsl + s0 + 8 * j + 4);
                u32x4 o; o.x = cvt_pk_bf16(w0.x * r0.x, w0.y * r0.y); o.y = cvt_pk_bf16(w0.z * r0.z, w0.w * r0.w); o.z = cvt_pk_bf16(w1.x * r1.x, w1.y * r1.y); o.w = cvt_pk_bf16(w1.z * r1.z, w1.w * r1.w);
                *(LAS u32x4*)(Wl + t * WSP + (s0 + 8 * j) * 2) = o; } }
        LDS_WAIT(); __syncthreads();
        if (more) P2_LOADV(P2_UNIT(i + 1));
        const int nks = th ? 4 : 2;
        LAS unsigned char* vbase = Vl + (8 * fq + (fr >> 2)) * VS + (wc * 96 + 8 * (fr & 3)) * 2;
        LAS unsigned char* wbase = Wl + (64 * th + fr) * WSP + (8 * fq) * 2;
#pragma unroll
        for (int p = 0; p < 3; ++p) {
            const int c0 = cb + 32 * p; const f32x4 ga = *(const f32x4*)(gain + c0), gb = *(const f32x4*)(gain + c0 + 4);
            f32x4 acc[4][2];
#pragma unroll
            for (int m = 0; m < 4; ++m) { acc[m][0] = (f32x4){0.f, 0.f, 0.f, 0.f}; acc[m][1] = (f32x4){0.f, 0.f, 0.f, 0.f}; }
            for (int ks = 0; ks < nks; ++ks) {
                bf16x8 wf[4], vf[2];
#pragma unroll
                for (int m = 0; m < 4; ++m) wf[m] = *(const LAS bf16x8*)(wbase + (16 * m) * WSP + (32 * ks) * 2);
#pragma unroll
                for (int n = 0; n < 2; ++n) { const s16x4 lo = lds_tr(vbase + (32 * ks) * VS + p * 64 + n * 8), hi = lds_tr(vbase + (32 * ks + 4) * VS + p * 64 + n * 8);
                    vf[n] = (bf16x8){lo[0], lo[1], lo[2], lo[3], hi[0], hi[1], hi[2], hi[3]}; }
#pragma unroll
                for (int m = 0; m < 4; ++m)
#pragma unroll
                    for (int n = 0; n < 2; ++n) acc[m][n] = __builtin_amdgcn_mfma_f32_16x16x32_bf16(vf[n], wf[m], acc[m][n], 0, 0, 0);
            }
#pragma unroll
            for (int m = 0; m < 4; ++m) { const int t = 64 * th + 16 * m + fr; const f32x4 s0 = acc[m][0] * ga + bb[m], s1 = acc[m][1] * gb + bb[m]; const u32x4 uv = uu[p][m];
                u32x4 o;
                o.x = cvt_pk_bf16(__uint_as_float(uv.x << 16) * s0[0], __uint_as_float(uv.x & 0xffff0000u) * s0[1]); o.y = cvt_pk_bf16(__uint_as_float(uv.y << 16) * s0[2], __uint_as_float(uv.y & 0xffff0000u) * s0[3]);
                o.z = cvt_pk_bf16(__uint_as_float(uv.z << 16) * s1[0], __uint_as_float(uv.z & 0xffff0000u) * s1[1]); o.w = cvt_pk_bf16(__uint_as_float(uv.w << 16) * s1[2], __uint_as_float(uv.w & 0xffff0000u) * s1[3]);
                if (!F.dry) *(u32x4*)(Z + (size_t)(blk * GBLK + t) * DFF + c0) = o; }
        }
        __syncthreads();
    }
#undef P2_UNIT
#undef P2_LOADV
}

__device__ __forceinline__ void p7_attention(Frame& F, const Args& a) {
    constexpr int KS = 144;
    constexpr int SLOT = 64 * KS;
    LAS unsigned char* Kl = F.lds; LAS unsigned char* Vl = F.lds + 2 * SLOT; LAS float* bl = (LAS float*)(F.lds + 4 * SLOT);
    const unsigned short* Qg = (const unsigned short*)(F.ws + WS_Q); const unsigned short* Kg = (const unsigned short*)(F.ws + WS_K); const unsigned short* Vg = (const unsigned short*)(F.ws + WS_V);
    unsigned short* Og = (unsigned short*)(F.ws + WS_O); const float* rel = a.in[13];
    const int tid = F.tid, lane = F.lane, w = F.wave, cw = w >> 1, fr = lane & 15, fq = lane >> 4;
    constexpr int NU = NB * NH * (SEQ / 256);
    const int lrow = tid >> 3, lch = tid & 7;
    for (int un = F.vcu; un < NU; un += F.G) {
        const int qb = un & 15, h = (un >> 4) & 15, b = un >> 8;
        const size_t rowb = (size_t)b * SEQ;
        __syncthreads();
        if (tid < 384) bl[tid] = rel[h * RELSZ + (tid < RELSZ ? tid : RELSZ - 1)] * LOG2E;
        bf16x8 qf[2][2];
#pragma unroll
        for (int qt = 0; qt < 2; ++qt)
#pragma unroll
            for (int ks = 0; ks < 2; ++ks) qf[qt][ks] = *(const bf16x8*)(Qg + (rowb + qb * 256 + 32 * w + 16 * qt + fr) * D + h * HD + 32 * ks + 8 * fq);
        f32x4 o[4][2];
#pragma unroll
        for (int dt = 0; dt < 4; ++dt) { o[dt][0] = (f32x4){0.f, 0.f, 0.f, 0.f}; o[dt][1] = (f32x4){0.f, 0.f, 0.f, 0.f}; }
        float mrun[2] = {-1e30f, -1e30f}, lrun[2] = {0.f, 0.f};
        const int jt0 = (4 * qb - 8 < 0) ? (8 - 4 * qb) : 0;
        u32x4 kreg, vreg;
        { const size_t krow = rowb + (size_t)(4 * qb - 8 + jt0) * 64 + lrow; kreg = *(const u32x4*)(Kg + krow * D + h * HD + lch * 8); vreg = *(const u32x4*)(Vg + krow * D + h * HD + lch * 8); }
        *(LAS u32x4*)(Kl + (jt0 & 1) * SLOT + lrow * KS + lch * 16) = kreg; *(LAS u32x4*)(Vl + (jt0 & 1) * SLOT + lrow * KS + lch * 16) = vreg;
        LDS_WAIT(); __syncthreads();
        for (int jt = jt0; jt < 12; ++jt) {
            const bool more = jt + 1 < 12;
            if (more) { const size_t krow = rowb + (size_t)(4 * qb - 8 + jt + 1) * 64 + lrow; kreg = *(const u32x4*)(Kg + krow * D + h * HD + lch * 8); vreg = *(const u32x4*)(Vg + krow * D + h * HD + lch * 8); }
            if (jt >= cw && jt <= cw + 8) {
                LAS unsigned char* Ks_ = Kl + (jt & 1) * SLOT; LAS unsigned char* Vs_ = Vl + (jt & 1) * SLOT;
                f32x4 sc[4][2];
#pragma unroll
                for (int it = 0; it < 4; ++it) { sc[it][0] = (f32x4){0.f, 0.f, 0.f, 0.f}; sc[it][1] = (f32x4){0.f, 0.f, 0.f, 0.f}; }
#pragma unroll
                for (int ks = 0; ks < 2; ++ks)
#pragma unroll
                    for (int it = 0; it < 4; ++it) { const bf16x8 kf = *(const LAS bf16x8*)(Ks_ + (16 * it + fr) * KS + (32 * ks + 8 * fq) * 2);
                        sc[it][0] = __builtin_amdgcn_mfma_f32_16x16x32_bf16(kf, qf[0][ks], sc[it][0], 0, 0, 0);
                        sc[it][1] = __builtin_amdgcn_mfma_f32_16x16x32_bf16(kf, qf[1][ks], sc[it][1], 0, 0, 0); }
                const int dchunk = cw + 8 - jt;
                if (dchunk <= 4) {
#pragma unroll
                    for (int qt = 0; qt < 2; ++qt) { const int qloc = 32 * (w & 1) + 16 * qt + fr;
#pragma unroll
                        for (int it = 0; it < 4; ++it)
#pragma unroll
                            for (int r = 0; r < 4; ++r) sc[it][qt][r] += bl[64 * dchunk + qloc - 4 * fq + (CHUNK - 1) - (16 * it + r)]; }
                } else { const float bc = bl[RELSZ - 1];
#pragma unroll
                    for (int it = 0; it < 4; ++it) { sc[it][0] = sc[it][0] + bc; sc[it][1] = sc[it][1] + bc; } }
                bf16x8 pf[2][2];
#pragma unroll
                for (int qt = 0; qt < 2; ++qt) {
                    float mx = sc[0][qt][0];
#pragma unroll
                    for (int it = 0; it < 4; ++it)
#pragma unroll
                        for (int r = 0; r < 4; ++r) mx = fmaxf(mx, sc[it][qt][r]);
                    mx = fmaxf(mx, __shfl_xor(mx, 16)); mx = fmaxf(mx, __shfl_xor(mx, 32));
                    const float mn = fmaxf(mrun[qt], mx), corr = __builtin_amdgcn_exp2f(mrun[qt] - mn); mrun[qt] = mn;
                    float ps = 0.f; float p[4][4];
#pragma unroll
                    for (int it = 0; it < 4; ++it)
#pragma unroll
                        for (int r = 0; r < 4; ++r) { p[it][r] = __builtin_amdgcn_exp2f(sc[it][qt][r] - mn); ps += p[it][r]; }
                    lrun[qt] = lrun[qt] * corr + ps;
                    if (__builtin_amdgcn_ballot_w64(corr != 1.0f)) {
#pragma unroll
                        for (int dt = 0; dt < 4; ++dt) o[dt][qt] = o[dt][qt] * corr; }
#pragma unroll
                    for (int kk = 0; kk < 2; ++kk) { u32x4 pk; pk.x = cvt_pk_bf16(p[2 * kk][0], p[2 * kk][1]); pk.y = cvt_pk_bf16(p[2 * kk][2], p[2 * kk][3]); pk.z = cvt_pk_bf16(p[2 * kk + 1][0], p[2 * kk + 1][1]); pk.w = cvt_pk_bf16(p[2 * kk + 1][2], p[2 * kk + 1][3]);
                        pf[kk][qt] = __builtin_bit_cast(bf16x8, pk); }
                }
                LAS unsigned char* vb = Vs_ + (4 * fq + (fr >> 2)) * KS + (4 * (fr & 3)) * 2;
#pragma unroll
                for (int kk = 0; kk < 2; ++kk)
#pragma unroll
                    for (int dt = 0; dt < 4; ++dt) { const s16x4 lo = lds_tr(vb + (32 * kk) * KS + dt * 32), hi = lds_tr(vb + (32 * kk + 16) * KS + dt * 32);
                        const bf16x8 vf = (bf16x8){lo[0], lo[1], lo[2], lo[3], hi[0], hi[1], hi[2], hi[3]};
                        o[dt][0] = __builtin_amdgcn_mfma_f32_16x16x32_bf16(vf, pf[kk][0], o[dt][0], 0, 0, 0);
                        o[dt][1] = __builtin_amdgcn_mfma_f32_16x16x32_bf16(vf, pf[kk][1], o[dt][1], 0, 0, 0); }
            }
            if (more) { *(LAS u32x4*)(Kl + ((jt + 1) & 1) * SLOT + lrow * KS + lch * 16) = kreg; *(LAS u32x4*)(Vl + ((jt + 1) & 1) * SLOT + lrow * KS + lch * 16) = vreg; }
            LDS_WAIT(); __syncthreads();
        }
#pragma unroll
        for (int qt = 0; qt < 2; ++qt) { float l = lrun[qt]; l += __shfl_xor(l, 16); l += __shfl_xor(l, 32); const float inv = 1.0f / l;
            unsigned short* orow = Og + (rowb + qb * 256 + 32 * w + 16 * qt + fr) * D + h * HD + 4 * fq;
#pragma unroll
            for (int dt = 0; dt < 4; ++dt) { const f32x4 v = o[dt][qt] * inv; u32x2 wv; wv.x = cvt_pk_bf16(v[0], v[1]); wv.y = cvt_pk_bf16(v[2], v[3]); *(u32x2*)(orow + 16 * dt) = wv; } }
    }
}


__device__ __forceinline__ void p12c_combine(Frame& F, const MoeOrder& MO, int L0, int R, int S) {
    const f32x4* P = (const f32x4*)(F.ws + WS_PART); unsigned short* Y = (unsigned short*)(F.ws + WS_Y); const float* slotw = (const float*)(F.ws + WS_SLOTW);
    const int j = F.vcu; if (j >= R * S) return;
    const int q = j / S, part = j % S, C = (16384 + S - 1) / S;
    Unit u; MO.fill(L0 + q, u);
    const int c1 = (part + 1) * C < 16384 ? (part + 1) * C : 16384;
    for (int cell = part * C + F.tid; cell < c1; cell += NWAVES * 64) {
        const int idx = cell >> 9, tid = cell & 511, n = idx & 1, m = (idx >> 1) & 3, bj = (idx >> 3) & 1, ai = idx >> 4;
        const int wid = tid >> 6, lane = tid & 63, wr = wid >> 2, wc = wid & 3, fr = lane & 15, fq = lane >> 4;
        f32x4 a = (f32x4){0.f, 0.f, 0.f, 0.f};
        for (int ks = 0; ks < S; ++ks) a = a + P[(size_t)(q * S + ks) * 16384 + cell];
        const int lrow = ai * HALF + wr * 64 + m * 16 + fr, row = u.pm * BM + lrow, col = u.pn * BM + bj * HALF + wc * 32 + 8 * fq + 4 * n;
        if (lrow < u.rows) { const float r = slotw[row]; u32x2 w; w.x = cvt_pk_bf16(a[0] * r, a[1] * r); w.y = cvt_pk_bf16(a[2] * r, a[3] * r); *(u32x2*)(Y + (size_t)row * D + col) = w; }
    }
}
__device__ __forceinline__ int split_of(int R, int G) { return R * 14 <= G ? 14 : R * 7 <= G ? 7 : R * 4 <= G ? 4 : R * 2 <= G ? 2 : 1; }

constexpr int NPH = 15;
__global__ void __launch_bounds__(NWAVES * 64, 2) fwd(Args args) {
    extern __shared__ __attribute__((aligned(16))) unsigned char lds_raw[];
    Frame F; F.lds = (LAS unsigned char*)lds_raw; F.MISC = (volatile LAS unsigned*)(F.lds + MISC_OFF);
    F.tid = threadIdx.x; F.lane = F.tid & 63; F.wave = __builtin_amdgcn_readfirstlane(F.tid >> 6);
    F.G = gridDim.x; { const int bx = blockIdx.x; F.vcu = (F.G % 8 == 0) ? (bx % 8) * (F.G / 8) + bx / 8 : bx; }
    F.ws = args.ws; F.ctl = (gu32*)(args.ws + WS_CTL); F.dry = 0;
    unsigned char* ws = args.ws;
    for (int u = F.tid; u < (LDS_BYTES - LDSCTL_OFF) / 4; u += NWAVES * 64) ((LAS unsigned*)(F.lds + LDSCTL_OFF))[u] = 0u;
    __syncthreads();
    const int lo = args.ph_lo, hi = args.ph_hi;
    XcdBarrier bar; bar.bar = (unsigned*)(F.ctl + CW_BAR); bar.x = 0; bar.st = nullptr;
    if (hi - lo > 1) bar = xcd_barrier_post((unsigned*)(F.ctl + CW_BAR), F.MISC + 8);
#define IN(k) (lo <= (k) && (k) < hi)
    unsigned long long ts_t0 = 0, ts_acc = 0;
#define TS_BEGIN(k) do { if ((PROBE_TS >> (k)) & 1) ts_t0 = __builtin_amdgcn_s_memrealtime(); } while (0)
#define TS_END(k) do { if ((PROBE_TS >> (k)) & 1) ts_acc += __builtin_amdgcn_s_memrealtime() - ts_t0; } while (0)
#define SEAM(k) do { if (IN(k) && IN((k) + 1)) xcd_barrier(bar); } while (0)
    const int bx = (int)blockIdx.x;
    unsigned short* XB = (unsigned short*)(ws + WS_XB);
    u64* ss0 = (u64*)(ws + WS_SS0); u64* ssv = (u64*)(ws + WS_SSV); u64* ss1 = (u64*)(ws + WS_SS1); u64* ss2 = (u64*)(ws + WS_SS2);

    TS_BEGIN(0);
    if (IN(0)) {
#if PROBE_REP == 0
        p0_prologue(F, args);
#endif
        p0_prologue(F, args); } SEAM(0); TS_END(0);
    TS_BEGIN(1);
    if (IN(1)) {
        DenseOrder S{T / BM, DFF / BM, F.G, bx}; EpiGeluZ E{(unsigned short*)(ws + WS_Z), ss0, ssv};
#if PROBE_REP == 1
        gemm_phase<EpiGeluZ, DenseOrder, true>(F.lds, (const char*)XB, (const char*)(ws + WS_WIN), D, D * 2, D * 2, S, E, (args.flags >> 16) & 1);
#endif
        gemm_phase<EpiGeluZ, DenseOrder, true>(F.lds, (const char*)XB, (const char*)(ws + WS_WIN), D, D * 2, D * 2, S, E);
    } SEAM(1); TS_END(1);
    TS_BEGIN(2);
    if (IN(2)) {
#if PROBE_REP == 2
        F.dry = (args.flags >> 16) & 1; p2_gating(F, args); F.dry = 0;
#endif
        p2_gating(F, args); } SEAM(2); TS_END(2);
    TS_BEGIN(3);
    if (IN(3)) {
        DenseOrder S{T / BM, D / BM, F.G, bx}; EpiResid<false> E{nullptr, XB, ss1, nullptr};
#if PROBE_REP == 3
        gemm_phase<EpiResid<false>, DenseOrder, false>(F.lds, (const char*)(ws + WS_Z), (const char*)(ws + WS_WOUT), HALFC, DFF * 2, HALFC * 2, S, E, (args.flags >> 16) & 1);
#endif
        gemm_phase<EpiResid<false>, DenseOrder, false>(F.lds, (const char*)(ws + WS_Z), (const char*)(ws + WS_WOUT), HALFC, DFF * 2, HALFC * 2, S, E);
    } SEAM(3); TS_END(3);
    TS_BEGIN(4);
    if (IN(4)) {
        DenseOrder S{T / BM, 2 * FFN / BM, F.G, bx}; EpiSwigluT<true> E{(unsigned short*)(ws + WS_H), FFN, ss1};
#if PROBE_REP == 4
        gemm_phase<EpiSwigluT<true>, DenseOrder, true>(F.lds, (const char*)XB, (const char*)(ws + WS_WGU), D, D * 2, D * 2, S, E, (args.flags >> 16) & 1);
#endif
        gemm_phase<EpiSwigluT<true>, DenseOrder, true>(F.lds, (const char*)XB, (const char*)(ws + WS_WGU), D, D * 2, D * 2, S, E);
        { const int rem = ((T / BM) * (2 * FFN / BM)) % F.G;
          if (rem == 0) side_convert_wed(F, args, bx, F.G); else if (bx >= rem) side_convert_wed(F, args, bx - rem, F.G - rem); }
    } SEAM(4); TS_END(4);
    TS_BEGIN(5);
    if (IN(5)) {
        DenseOrder S{T / BM, D / BM, F.G, bx}; EpiResid<false> E{nullptr, XB, ss2, nullptr};
#if PROBE_REP == 5
        gemm_phase<EpiResid<false>, DenseOrder, false>(F.lds, (const char*)(ws + WS_H), (const char*)(ws + WS_WD), FFN, FFN * 2, FFN * 2, S, E, (args.flags >> 16) & 1);
#endif
        gemm_phase<EpiResid<false>, DenseOrder, false>(F.lds, (const char*)(ws + WS_H), (const char*)(ws + WS_WD), FFN, FFN * 2, FFN * 2, S, E);
    } SEAM(5); TS_END(5);
    TS_BEGIN(6);
    if (IN(6)) {
        DenseOrder S{T / BM, 3 * D / BM, F.G, bx}; EpiQKV E{(unsigned short*)(ws + WS_Q), (size_t)(WS_K - WS_Q) / 2, ss2, (args.flags & FL_QSCALE1) ? 1.0f : 0.125f * LOG2E};
#if PROBE_REP == 6
        gemm_phase<EpiQKV, DenseOrder, true>(F.lds, (const char*)XB, (const char*)(ws + WS_WQKV), D, D * 2, D * 2, S, E, (args.flags >> 16) & 1);
#endif
        gemm_phase<EpiQKV, DenseOrder, true>(F.lds, (const char*)XB, (const char*)(ws + WS_WQKV), D, D * 2, D * 2, S, E);
    } SEAM(6); TS_END(6);
    TS_BEGIN(7);
    if (IN(7)) {
#if PROBE_REP == 7
        p7_attention(F, args);
#endif
        p7_attention(F, args); } SEAM(7); TS_END(7);
    TS_BEGIN(8);
    if (IN(8)) {
        DenseOrder S{T / BM, D / BM, F.G, bx}; EpiResid<false> E{nullptr, XB, nullptr, nullptr};
#if PROBE_REP == 8
        gemm_phase<EpiResid<false>, DenseOrder, false>(F.lds, (const char*)(ws + WS_O), (const char*)(ws + WS_WO), D, D * 2, D * 2, S, E, (args.flags >> 16) & 1);
#endif
        gemm_phase<EpiResid<false>, DenseOrder, false>(F.lds, (const char*)(ws + WS_O), (const char*)(ws + WS_WO), D, D * 2, D * 2, S, E);
    } SEAM(8); TS_END(8);
    TS_BEGIN(9);
    if (IN(9)) {
#if PROBE_REP == 9
        F.dry = 1; p9_router(F, args); F.dry = 0;
#endif
        p9_router(F, args); } SEAM(9); TS_END(9);
    TS_BEGIN(10);
    if (IN(10)) {
#if PROBE_REP == 9
        F.dry = 1; p9b_gather(F, args); F.dry = 0;
#endif
        p9b_gather(F, args); } SEAM(10); TS_END(10);
    TS_BEGIN(11);
    if (IN(11)) {
        MoeOrder S; S.init((const int*)(F.ctl + CW_CNT), 2 * EDIM / BM, F.G, bx, 2 * EDIM); EpiSwigluT<false> E{(unsigned short*)(ws + WS_HM), EDIM, nullptr};
#if PROBE_REP == 11
        gemm_phase<EpiSwigluT<false>, MoeOrder, true, true>(F.lds, (const char*)(ws + WS_X3N), (const char*)(ws + WS_WEGU), D, D * 2, D * 2, S, E, (args.flags >> 16) & 1, (const int*)(ws + WS_SLOTTOK));
#endif
        gemm_phase<EpiSwigluT<false>, MoeOrder, true, true>(F.lds, (const char*)(ws + WS_X3N), (const char*)(ws + WS_WEGU), D, D * 2, D * 2, S, E, 0, (const int*)(ws + WS_SLOTTOK));
    } SEAM(11); TS_END(11);
    TS_BEGIN(12);
    if (IN(12)) {
        MoeOrder S; S.init((const int*)(F.ctl + CW_CNT), D / BM, F.G, bx, D); S.rev = 1; EpiMoe2 E{(unsigned short*)(ws + WS_Y), (const float*)(ws + WS_SLOTW)};
        const int nwg = S.nM * S.nN, L0 = (nwg / F.G) * F.G, R = nwg - L0, SP = split_of(R, F.G < PART_CAP ? F.G : PART_CAP);
        S.Lend = L0;
        gemm_phase<EpiMoe2, MoeOrder, true>(F.lds, (const char*)(ws + WS_HM), (const char*)(ws + WS_WED), EDIM, EDIM * 2, EDIM * 2, S, E);
        if (R > 0) { MoeSplit S2{S, L0, R, SP, (EDIM / SP) * 2}; EpiPartial E2{(f32x4*)(ws + WS_PART)};
            gemm_phase<EpiPartial, MoeSplit, true>(F.lds, (const char*)(ws + WS_HM), (const char*)(ws + WS_WED), EDIM / SP, EDIM * 2, EDIM * 2, S2, E2); }
    } SEAM(12); TS_END(12);
    TS_BEGIN(13);
    if (IN(13)) { MoeOrder S; S.init((const int*)(F.ctl + CW_CNT), D / BM, F.G, bx, D); S.rev = 1; const int nwg = S.nM * S.nN, L0 = (nwg / F.G) * F.G, R = nwg - L0;
        if (R > 0) p12c_combine(F, S, L0, R, split_of(R, F.G < PART_CAP ? F.G : PART_CAP)); } SEAM(13); TS_END(13);
    TS_BEGIN(14);
    if (IN(14)) {
#if PROBE_REP == 9
        F.dry = 1; p12_final(F, args); F.dry = 0;
#endif
        p12_final(F, args); } TS_END(14);
    if (PROBE_TS != 0 && blockIdx.x == 0) { const unsigned long long te = __builtin_amdgcn_s_memrealtime(); while (__builtin_amdgcn_s_memrealtime() - te < ts_acc) __builtin_amdgcn_s_sleep(8); }
#undef IN
#undef SEAM
}
}
extern "C" void kernel_launch(void* const* d_in, const int* in_sizes, int n_in, void* d_out, int out_size, void* d_ws, size_t ws_size, hipStream_t stream) {
    static int grid = 0;
    if (grid == 0) {
        if (n_in != 20 || out_size != mk::T * mk::D || ws_size < mk::WS_END) { fprintf(stderr, "kernel_launch: unexpected sizes (ws %zu)\n", ws_size); grid = -1; return; }
        int dev = 0, cus = 0;
        if (hipGetDevice(&dev) != hipSuccess || hipDeviceGetAttribute(&cus, hipDeviceAttributeMultiprocessorCount, dev) != hipSuccess) { grid = -1; return; }
        if (hipFuncSetAttribute((const void*)mk::fwd, hipFuncAttributeMaxDynamicSharedMemorySize, mk::LDS_BYTES) != hipSuccess) { fprintf(stderr, "kernel_launch: hipFuncSetAttribute failed\n"); grid = -1; return; }
        if (cus < 256) { fprintf(stderr, "kernel_launch: built for a 256-CU device (every workgroup must be resident: one per CU); this device has %d CUs; nothing launched\n", cus); grid = -1; return; }
        grid = 256;
    }
    if (grid < 0) return;
    unsigned char* ws = (unsigned char*)d_ws;
    (void)hipMemsetAsync(ws + mk::WS_CTL, 0, mk::CTL_ZERO_BYTES, stream);
    mk::Args a; for (int i = 0; i < 20; ++i) a.in[i] = (const float*)d_in[i];
    a.out = (float*)d_out; a.ws = ws; a.flags = mk::FL_L0 | mk::FL_EXPERTS | (PROBE_REP << 8) | (PROBE_DRY << 16); a.pad = 0;
    a.ph_lo = 0; a.ph_hi = mk::NPH; hipLaunchKernelGGL(mk::fwd, dim3(grid), dim3(512), mk::LDS_BYTES, stream, a);
}
```

```cpp
#include <hip/hip_runtime.h>
#include <cstdint>
#include <cstdio>

typedef unsigned short bf16_t;
#ifndef PROBE_REP
#define PROBE_REP 0xff
#endif
#ifndef PROBE_DRY
#define PROBE_DRY 1
#endif
#ifndef PROBE_TS
#define PROBE_TS 0
#endif
namespace mk {
#define LAS __attribute__((address_space(3)))
#define GAS __attribute__((address_space(1)))
typedef short bf16x8 __attribute__((ext_vector_type(8)));
typedef short s16x4 __attribute__((ext_vector_type(4)));
typedef float f32x4 __attribute__((ext_vector_type(4)));
typedef float f32x2 __attribute__((ext_vector_type(2)));
typedef unsigned u32x4 __attribute__((ext_vector_type(4)));
typedef unsigned u32x2 __attribute__((ext_vector_type(2)));
typedef GAS unsigned gu32;

constexpr int T = 16384, D = 1024, SEQ = 4096, NB = 4;
constexpr int DFF = 6144, HALFC = 3072, GRP = 8, GDIM = 384, GBLK = 128, CHUNK = 64;
constexpr int NH = 16, HD = 64, LEFT = 8, RELSZ = 320, RELCLIP = 256;
constexpr int FFN = 2816, NE = 8, EDIM = 3584;
constexpr int SLOTS = 34816;
constexpr float EPS = 1e-6f;
constexpr float LOG2E = 1.4426950408889634f;

constexpr size_t KiB = 1024, MiB = 1u << 20;
constexpr size_t WS_CTL = 0, CTL_ZERO_BYTES = 1 * MiB;
constexpr size_t WS_SS0 = 128 * KiB, WS_SSV = 256 * KiB, WS_SS1 = 384 * KiB, WS_SS2 = 512 * KiB;
constexpr size_t WS_LIST = 1 * MiB, WS_TOKSLOT = WS_LIST + 512 * KiB, WS_TOKW = WS_TOKSLOT + 256 * KiB, WS_R3 = 2 * MiB, WS_SLOTW = WS_R3 + 256 * KiB, WS_SLOTTOK = WS_LIST + 64 * KiB;
constexpr size_t WS_WEGU = 4 * MiB, WS_WED = 116 * MiB;
constexpr size_t WS_WIN = 172 * MiB, WS_WOUT = 184 * MiB, WS_WGU = 190 * MiB, WS_WD = 201 * MiB, WS_WQKV = 207 * MiB, WS_WO = 213 * MiB;
constexpr size_t WS_XB = 215 * MiB;
constexpr size_t WS_Z = 247 * MiB;
constexpr size_t WS_H = 247 * MiB;
constexpr size_t WS_Q = 247 * MiB, WS_K = 279 * MiB, WS_V = 311 * MiB, WS_O = 343 * MiB;
constexpr size_t WS_X3N = 172 * MiB;
constexpr size_t WS_PART = 172 * MiB; constexpr int PART_CAP = 172;
constexpr size_t WS_HM = 247 * MiB;
constexpr size_t WS_Y = 4 * MiB;
constexpr size_t WS_END = 485 * MiB;
static_assert(WS_HM + (size_t)SLOTS * EDIM * 2 <= WS_END && WS_X3N + (size_t)T * D * 2 <= WS_XB && WS_PART + (size_t)PART_CAP * 262144 <= WS_XB && WS_XB + (size_t)T * D * 2 <= WS_HM && WS_Z + (size_t)T * DFF * 2 <= WS_END && WS_WO + 2 * MiB <= WS_XB, "ws map");
constexpr int CW_TMO = 0, CW_CNT = 64, CW_BAR = 4096;

constexpr int RING_BYTES = 131072, LDSCTL_OFF = 143360, MISC_OFF = LDSCTL_OFF + 320, LDS_BYTES = 147456;
constexpr int NWAVES = 8;

#define RLX_AGENT __ATOMIC_RELAXED, __HIP_MEMORY_SCOPE_AGENT
typedef unsigned long long u64;
constexpr float SS_SCALE = 16777216.0f, SS_INV = 1.0f / 16777216.0f;
__device__ __forceinline__ float rs_of(const u64* ss, int row, float inv_n) { return rsqrtf((float)ss[row] * (SS_INV * inv_n) + 1e-6f); }
__device__ __forceinline__ void ss_add(u64* ss, int row, float q) { __hip_atomic_fetch_add(ss + row, (u64)(q * SS_SCALE), RLX_AGENT); }
#define LDS_WAIT() asm volatile("s_waitcnt lgkmcnt(0)" ::: "memory")
#define VM_WAIT() asm volatile("s_waitcnt vmcnt(0)" ::: "memory")
__device__ __forceinline__ unsigned cvt_pk_bf16(float lo, float hi) { unsigned r; asm volatile("v_cvt_pk_bf16_f32 %0, %1, %2" : "=v"(r) : "v"(lo), "v"(hi)); return r; }
__device__ __forceinline__ float bf2f(unsigned short b) { return __uint_as_float(((unsigned)b) << 16); }
__device__ __forceinline__ float wave_sum(float v) {
#pragma unroll
    for (int o = 1; o < 64; o <<= 1) v += __shfl_xor(v, o);
    return v;
}

#define XB_TMO      128
#define XB_XCNT(j)  (256  + 64 * (j))
#define XB_XSUB(j)  (1280 + 64 * (j))
#define XB_XGEN(j)  (2304 + 64 * (j))
#define XB_TOP      3328
#define XB_TOPGEN   3392
#define XCD_BAR_WORDS 3456
#define XB_SPIN_CAP (1u << 18)
__device__ __forceinline__ unsigned xb_ld(unsigned* p)              { return __hip_atomic_load(p, __ATOMIC_RELAXED, __HIP_MEMORY_SCOPE_AGENT); }
__device__ __forceinline__ unsigned xb_add(unsigned* p, unsigned v) { return __hip_atomic_fetch_add(p, v, __ATOMIC_RELAXED, __HIP_MEMORY_SCOPE_AGENT); }
__device__ __forceinline__ unsigned xb_xcc_id() { return (unsigned)__builtin_amdgcn_s_getreg((3 << 11) | 20) & 0xFu; }
#define XB_SPIN(cond, bar) do { unsigned _sp = 0; while (cond) { __builtin_amdgcn_s_sleep(1); \
    if ((++_sp & 255u) == 0u) { if (xb_ld(&(bar)[XB_TMO])) break; if (_sp > XB_SPIN_CAP) { atomicAdd(&(bar)[XB_TMO], 1u); break; } } } } while (0)
struct XcdBarrier { unsigned* bar; unsigned x; volatile LAS unsigned* st; };
__device__ __forceinline__ XcdBarrier xcd_barrier_post(unsigned* bar, volatile LAS unsigned* st) {
    XcdBarrier b; b.bar = bar; b.x = xb_xcc_id(); b.st = st;
    if (threadIdx.x == 0) (void)xb_add(&bar[XB_XCNT(b.x)], 1u);
    return b;
}
__device__ __forceinline__ void xcd_barrier_complete(unsigned* bar, unsigned x, unsigned& nloc, unsigned& nx) {
    const unsigned G = gridDim.x * gridDim.y * gridDim.z;
    unsigned sum, cnt, mine, sp = 0u;
    for (;;) {
        sum = 0u; cnt = 0u; mine = 0u;
#pragma unroll
        for (unsigned j = 0; j < 16; ++j) { const unsigned c = xb_ld(&bar[XB_XCNT(j)]); sum += c; cnt += (c > 0u) ? 1u : 0u; mine = (j == x) ? c : mine; }
        if (sum == G) break;
        __builtin_amdgcn_s_sleep(1);
        if ((++sp & 255u) == 0u) { if (xb_ld(&bar[XB_TMO])) break; if (sp > XB_SPIN_CAP) { atomicAdd(&bar[XB_TMO], 1u); break; } }
    }
    nloc = mine > 0u ? mine : 1u; nx = cnt > 0u ? cnt : 1u;
}
__device__ __forceinline__ void xcd_barrier(const XcdBarrier& b) {
    asm volatile("s_waitcnt vmcnt(0)" ::: "memory");
    __syncthreads();
    if (threadIdx.x == 0) {
        unsigned* bar = b.bar;
        __builtin_amdgcn_s_waitcnt(0);
        unsigned nloc = b.st[0], nx = b.st[1];
        if (nloc == 0u) { xcd_barrier_complete(bar, b.x, nloc, nx); b.st[0] = nloc; b.st[1] = nx; }
        const unsigned old = xb_add(&bar[XB_XSUB(b.x)], 1u);
        const unsigned gen = old / nloc;
        if (old + 1u == (gen + 1u) * nloc) {
            __builtin_amdgcn_fence(__ATOMIC_RELEASE, "agent");
            asm volatile("s_waitcnt vmcnt(0)" ::: "memory");
            const unsigned og = xb_add(&bar[XB_TOP], 1u);
            const unsigned tg = og / nx;
            if (og + 1u == (tg + 1u) * nx) xb_add(&bar[XB_TOPGEN], 1u);
            else XB_SPIN(xb_ld(&bar[XB_TOPGEN]) == tg, bar);
            __builtin_amdgcn_fence(__ATOMIC_ACQUIRE, "agent");
            xb_add(&bar[XB_XGEN(b.x)], 1u);
            asm volatile("s_waitcnt vmcnt(0)" ::: "memory");
        } else {
            XB_SPIN(xb_ld(&bar[XB_XGEN(b.x)]) == gen, bar);
            __builtin_amdgcn_fence(__ATOMIC_ACQUIRE, "agent");
            asm volatile("s_waitcnt vmcnt(0)" ::: "memory");
        }
    }
    __syncthreads();
}

constexpr int BM = 256, BK = 64, HALF = 128, HTB = HALF * BK * 2, NXCD = 8, WGM = 8;
__device__ __forceinline__ int lds_byte(int r, int c) { const int st = (r >> 4) * 2 + (c >> 5), rr = r & 15, cc = c & 31, ob = rr * 64 + cc * 2; return st * 1024 + (ob ^ (((ob >> 9) & 1) << 5)); }
__device__ __forceinline__ void stage_rc(int b, int& R, int& C) { const int st = b / 1024, sb = b % 1024, swz = sb ^ (((sb >> 9) & 1) << 5); R = (st >> 1) * 16 + swz / 64; C = (st & 1) * 32 + (swz % 64) / 2; }
__device__ __forceinline__ int perm32(int rho) { const int n = rho >> 4, i = rho & 15; return 8 * (i >> 2) + 4 * n + (i & 3); }

struct Unit { int pm, pn, e, rows; int arow, brow; int koff, sub; };

__device__ __forceinline__ void tile_of(int L, int nM, int nN, int& pm, int& pn) {
    const int nwg = nM * nN; int wgid = L;
    { const int q = nwg / NXCD, r = nwg % NXCD, xcd = wgid % NXCD, off = wgid / NXCD; wgid = (xcd < r ? xcd * (q + 1) : r * (q + 1) + (xcd - r) * q) + off; }
    const int nig = WGM * nN, gid = wgid / nig, fm = gid * WGM, gsz = (nM - fm) < WGM ? (nM - fm) : WGM;
    pm = fm + ((wgid % nig) % gsz); pn = (wgid % nig) / gsz;
}
struct DenseOrder {
    int nM, nN, G, c;
    __device__ __forceinline__ bool next(int i, Unit& u) const {
        const long L = (long)i * G + c; if (L >= (long)nM * nN) return false;
        tile_of((int)L, nM, nN, u.pm, u.pn); u.e = 0; u.rows = BM; u.arow = u.pm * BM; u.brow = u.pn * BM; u.koff = 0; u.sub = 0; return true;
    }
};
struct MoeOrder {
    int t1, t2, t3, t4, t5, t6, t7, nM, nN, G, c, bexp; int c0, c1, c2, c3, c4, c5, c6, c7; int Lend, rev;
    __device__ __forceinline__ void init(const int* cnt, int nN_, int G_, int c_, int bexp_) {
        c0 = cnt[0]; c1 = cnt[1]; c2 = cnt[2]; c3 = cnt[3]; c4 = cnt[4]; c5 = cnt[5]; c6 = cnt[6]; c7 = cnt[7];
        t1 = (c0 + 255) >> 8; t2 = t1 + ((c1 + 255) >> 8); t3 = t2 + ((c2 + 255) >> 8); t4 = t3 + ((c3 + 255) >> 8); t5 = t4 + ((c4 + 255) >> 8); t6 = t5 + ((c5 + 255) >> 8); t7 = t6 + ((c6 + 255) >> 8);
        nM = t7 + ((c7 + 255) >> 8); nN = nN_; G = G_; c = c_; bexp = bexp_; Lend = nM * nN; rev = 0;
    }
    __device__ __forceinline__ void fill(int L, Unit& u) const {
        tile_of(L, nM, nN, u.pm, u.pn); if (rev) u.pm = nM - 1 - u.pm;
        const int pm = u.pm; const int e = (pm >= t1) + (pm >= t2) + (pm >= t3) + (pm >= t4) + (pm >= t5) + (pm >= t6) + (pm >= t7);
        const int tb = e == 0 ? 0 : e == 1 ? t1 : e == 2 ? t2 : e == 3 ? t3 : e == 4 ? t4 : e == 5 ? t5 : e == 6 ? t6 : t7;
        const int ce = e == 0 ? c0 : e == 1 ? c1 : e == 2 ? c2 : e == 3 ? c3 : e == 4 ? c4 : e == 5 ? c5 : e == 6 ? c6 : c7;
        const int left = ce - (pm - tb) * BM;
        u.e = e; u.rows = left < BM ? left : BM; u.arow = pm * BM; u.brow = e * bexp + u.pn * BM; u.koff = 0; u.sub = 0;
    }
    __device__ __forceinline__ bool next(int i, Unit& u) const { const long L = (long)i * G + c; if (L >= (long)Lend) return false; fill((int)L, u); return true; }
    __device__ __forceinline__ int arow_of(int i) const { const long L = (long)i * G + c; if (L >= (long)Lend) return -1; int pm, pn; tile_of((int)L, nM, nN, pm, pn); return pm * BM; }
};
struct MoeSplit { MoeOrder base; int L0, R, S, klen;
    __device__ __forceinline__ bool next(int i, Unit& u) const { const long j = (long)i * base.G + base.c; if (j >= (long)R * S) return false;
        base.fill(L0 + (int)(j / S), u); u.koff = (int)(j % S) * klen; u.sub = (int)j; return true; }
};

__device__ __forceinline__ f32x2 gelu_pk(f32x2 v) {
    const f32x2 av = __builtin_elementwise_abs(v), d = av * 0.2316418882f + 1.0f;
    f32x2 t; t.x = __builtin_amdgcn_rcpf(d.x); t.y = __builtin_amdgcn_rcpf(d.y);
    f32x2 q = t * 0.5307027145f + (-0.7265760135f); q = q * t + 0.7107068705f; q = q * t + (-0.142248368f); q = q * t + 0.127414796f; q = q * t;
    const f32x2 s = (v * v) * (-0.72134752044f);
    f32x2 e; e.x = __builtin_amdgcn_exp2f(s.x); e.y = __builtin_amdgcn_exp2f(s.y);
    const f32x2 m = v * (q * e), r = v - m;
    f32x2 o; o.x = v.x < 0.f ? m.x : r.x; o.y = v.y < 0.f ? m.y : r.y; return o;
}
__device__ __forceinline__ f32x2 gelu_poly(f32x2 v) {
    f32x2 vc; vc.x = __builtin_fminf(__builtin_fmaxf(v.x, -4.0f), 4.0f); vc.y = __builtin_fminf(__builtin_fmaxf(v.y, -4.0f), 4.0f);
    const f32x2 tp = (vc * vc) * 0.125f - 1.0f;
    f32x2 p = tp * (-4.910800148e-04f) + 1.554953273e-03f; p = p * tp + (-2.861224474e-03f); p = p * tp + 5.916367646e-03f; p = p * tp + (-1.241304364e-02f); p = p * tp + 2.262065592e-02f;
    p = p * tp + (-3.688757600e-02f); p = p * tp + 5.592306942e-02f; p = p * tp + (-8.432015039e-02f); p = p * tp + 1.759499681e-01f;
    return v * (vc * p + 0.5f);
}
__device__ __forceinline__ float silu_f(float v) { return v * __builtin_amdgcn_rcpf(1.0f + __builtin_amdgcn_exp2f(-LOG2E * v)); }

typedef f32x4 Acc[2][2][4][2];
struct EpiGeluZ { static constexpr bool PERM = true;
    unsigned short* Z; const u64* ss; u64* ssv;
    __device__ __forceinline__ void operator()(const Acc& acc, const Unit& u, int wr, int wc, int fr, int fq) const {
        const int row0 = u.pm * BM + wr * 64 + fr, col0 = u.pn * BM + wc * 32 + 8 * fq; const bool isv = u.pn >= (HALFC / BM);
        float rr[2][4];
#pragma unroll
        for (int ai = 0; ai < 2; ++ai)
#pragma unroll
            for (int m = 0; m < 4; ++m) rr[ai][m] = rs_of(ss, row0 + ai * HALF + m * 16, 1.0f / D);
        asm volatile("" ::: "memory");
#pragma unroll
        for (int ai = 0; ai < 2; ++ai)
#pragma unroll
            for (int m = 0; m < 4; ++m) { const int row = row0 + ai * HALF + m * 16; const float r = rr[ai][m]; float q = 0.f;
                unsigned short* rowp = Z + (size_t)row * DFF + col0;
#pragma unroll
                for (int bj = 0; bj < 2; ++bj) { const f32x4 v0 = acc[ai][bj][m][0] * r, v1 = acc[ai][bj][m][1] * r;
                    const f32x2 a = gelu_poly((f32x2){v0[0], v0[1]}), b = gelu_poly((f32x2){v0[2], v0[3]}), c = gelu_poly((f32x2){v1[0], v1[1]}), d = gelu_poly((f32x2){v1[2], v1[3]});
                    q += (a.x * a.x + a.y * a.y) + (b.x * b.x + b.y * b.y) + (c.x * c.x + c.y * c.y) + (d.x * d.x + d.y * d.y);
                    u32x4 w; w.x = cvt_pk_bf16(a.x, a.y); w.y = cvt_pk_bf16(b.x, b.y); w.z = cvt_pk_bf16(c.x, c.y); w.w = cvt_pk_bf16(d.x, d.y);
                    *(u32x4*)(rowp + bj * HALF) = w; }
                if (isv) { q += __shfl_xor(q, 16); q += __shfl_xor(q, 32); if (fq == 0) ss_add(ssv, row, q); } }
    }
};
template <bool F32IN, bool F32OUT = false> struct EpiResid { static constexpr bool PERM = true;
    const float* xin; unsigned short* XB; u64* ss; float* xout;
    __device__ __forceinline__ void operator()(const Acc& acc, const Unit& u, int wr, int wc, int fr, int fq) const {
        const int row0 = u.pm * BM + wr * 64 + fr, col0 = u.pn * BM + wc * 32 + 8 * fq;
#pragma unroll
        for (int ai = 0; ai < 2; ++ai) {
            f32x4 pre[4][2][2];
#pragma unroll
            for (int m = 0; m < 4; ++m) { const size_t off = (size_t)(row0 + ai * HALF + m * 16) * D + col0;
#pragma unroll
                for (int bj = 0; bj < 2; ++bj) {
                    if (F32IN) { pre[m][bj][0] = *(const f32x4*)(xin + off + bj * HALF); pre[m][bj][1] = *(const f32x4*)(xin + off + bj * HALF + 4); }
                    else { const u32x4 w = *(const u32x4*)(XB + off + bj * HALF);
                        pre[m][bj][0] = (f32x4){__uint_as_float(w.x << 16), __uint_as_float(w.x & 0xffff0000u), __uint_as_float(w.y << 16), __uint_as_float(w.y & 0xffff0000u)};
                        pre[m][bj][1] = (f32x4){__uint_as_float(w.z << 16), __uint_as_float(w.z & 0xffff0000u), __uint_as_float(w.w << 16), __uint_as_float(w.w & 0xffff0000u)}; } } }
            asm volatile("" ::: "memory");
#pragma unroll
            for (int m = 0; m < 4; ++m) { const int row = row0 + ai * HALF + m * 16; const size_t off = (size_t)row * D + col0; float q = 0.f;
#pragma unroll
                for (int bj = 0; bj < 2; ++bj) { const f32x4 o0 = pre[m][bj][0] + acc[ai][bj][m][0], o1 = pre[m][bj][1] + acc[ai][bj][m][1];
                    q += (o0[0] * o0[0] + o0[1] * o0[1]) + (o0[2] * o0[2] + o0[3] * o0[3]) + (o1[0] * o1[0] + o1[1] * o1[1]) + (o1[2] * o1[2] + o1[3] * o1[3]);
                    if (F32OUT) { *(f32x4*)(xout + off + bj * HALF) = o0; *(f32x4*)(xout + off + bj * HALF + 4) = o1; }
                    else { u32x4 w; w.x = cvt_pk_bf16(o0[0], o0[1]); w.y = cvt_pk_bf16(o0[2], o0[3]); w.z = cvt_pk_bf16(o1[0], o1[1]); w.w = cvt_pk_bf16(o1[2], o1[3]);
                        *(u32x4*)(XB + off + bj * HALF) = w; } }
                if (ss) { q += __shfl_xor(q, 16); q += __shfl_xor(q, 32); if (fq == 0) ss_add(ss, row, q); } }
            asm volatile("" ::: "memory");
        }
    }
};
__device__ __forceinline__ unsigned swiglu_pk(f32x2 g, f32x2 u) {
    const f32x2 t = g * (-LOG2E); f32x2 e; e.x = __builtin_amdgcn_exp2f(t.x); e.y = __builtin_amdgcn_exp2f(t.y);
    const f32x2 d = e + 1.0f; f32x2 rc; rc.x = __builtin_amdgcn_rcpf(d.x); rc.y = __builtin_amdgcn_rcpf(d.y);
    const f32x2 o = (g * u) * rc; return cvt_pk_bf16(o.x, o.y);
}
template <bool SCALED> struct EpiSwigluT { static constexpr bool PERM = true;
    unsigned short* H; int ldo; const u64* ss;
    __device__ __forceinline__ void operator()(const Acc& acc, const Unit& u, int wr, int wc, int fr, int fq) const {
        const int row0 = u.pm * BM + wr * 64 + fr, col0 = u.pn * HALF + wc * 32 + 8 * fq, lrow0 = wr * 64 + fr;
        float rr[2][4];
        if constexpr (SCALED) {
#pragma unroll
            for (int ai = 0; ai < 2; ++ai)
#pragma unroll
                for (int m = 0; m < 4; ++m) rr[ai][m] = rs_of(ss, row0 + ai * HALF + m * 16, 1.0f / D);
            asm volatile("" ::: "memory"); }
#pragma unroll
        for (int ai = 0; ai < 2; ++ai)
#pragma unroll
            for (int m = 0; m < 4; ++m) { const int row = row0 + ai * HALF + m * 16;
                f32x4 g0 = acc[ai][0][m][0], g1 = acc[ai][0][m][1], u0 = acc[ai][1][m][0], u1 = acc[ai][1][m][1];
                if constexpr (SCALED) { const float r = rr[ai][m]; g0 = g0 * r; g1 = g1 * r; u0 = u0 * r; u1 = u1 * r; }
                u32x4 w; w.x = swiglu_pk((f32x2){g0[0], g0[1]}, (f32x2){u0[0], u0[1]}); w.y = swiglu_pk((f32x2){g0[2], g0[3]}, (f32x2){u0[2], u0[3]});
                w.z = swiglu_pk((f32x2){g1[0], g1[1]}, (f32x2){u1[0], u1[1]}); w.w = swiglu_pk((f32x2){g1[2], g1[3]}, (f32x2){u1[2], u1[3]});
                if (lrow0 + ai * HALF + m * 16 < u.rows) *(u32x4*)(H + (size_t)row * ldo + col0) = w; }
    }
};
struct EpiQKV { static constexpr bool PERM = true;
    unsigned short* Q; size_t tstride; const u64* ss; float qscale;
    __device__ __forceinline__ void operator()(const Acc& acc, const Unit& u, int wr, int wc, int fr, int fq) const {
        const int t = u.pn >> 2; unsigned short* base = Q + (size_t)t * tstride; const float sc = t == 0 ? qscale : 1.0f;
        const int row0 = u.pm * BM + wr * 64 + fr, col0 = (u.pn & 3) * BM + wc * 32 + 8 * fq;
        float rr[2][4];
#pragma unroll
        for (int ai = 0; ai < 2; ++ai)
#pragma unroll
            for (int m = 0; m < 4; ++m) rr[ai][m] = rs_of(ss, row0 + ai * HALF + m * 16, 1.0f / D) * sc;
        asm volatile("" ::: "memory");
#pragma unroll
        for (int ai = 0; ai < 2; ++ai)
#pragma unroll
            for (int m = 0; m < 4; ++m) { const int row = row0 + ai * HALF + m * 16; const float r = rr[ai][m];
                unsigned short* rowp = base + (size_t)row * D + col0;
#pragma unroll
                for (int bj = 0; bj < 2; ++bj) { const f32x4 v0 = acc[ai][bj][m][0] * r, v1 = acc[ai][bj][m][1] * r;
                    u32x4 w; w.x = cvt_pk_bf16(v0[0], v0[1]); w.y = cvt_pk_bf16(v0[2], v0[3]); w.z = cvt_pk_bf16(v1[0], v1[1]); w.w = cvt_pk_bf16(v1[2], v1[3]);
                    *(u32x4*)(rowp + bj * HALF) = w; } }
    }
};
struct EpiMoe2 { static constexpr bool PERM = true;
    unsigned short* Y; const float* slotw;
    __device__ __forceinline__ void operator()(const Acc& acc, const Unit& u, int wr, int wc, int fr, int fq) const {
        const int row0 = u.pm * BM + wr * 64 + fr, col0 = u.pn * BM + wc * 32 + 8 * fq, lrow0 = wr * 64 + fr;
        float rr[2][4];
#pragma unroll
        for (int ai = 0; ai < 2; ++ai)
#pragma unroll
            for (int m = 0; m < 4; ++m) rr[ai][m] = (lrow0 + ai * HALF + m * 16 < u.rows) ? slotw[row0 + ai * HALF + m * 16] : 0.f;
        asm volatile("" ::: "memory");
#pragma unroll
        for (int ai = 0; ai < 2; ++ai)
#pragma unroll
            for (int m = 0; m < 4; ++m) { const int row = row0 + ai * HALF + m * 16; const bool ok = lrow0 + ai * HALF + m * 16 < u.rows; const float r = rr[ai][m];
                unsigned short* rowp = Y + (size_t)row * D + col0;
#pragma unroll
                for (int bj = 0; bj < 2; ++bj) { const f32x4 v0 = acc[ai][bj][m][0] * r, v1 = acc[ai][bj][m][1] * r;
                    u32x4 w; w.x = cvt_pk_bf16(v0[0], v0[1]); w.y = cvt_pk_bf16(v0[2], v0[3]); w.z = cvt_pk_bf16(v1[0], v1[1]); w.w = cvt_pk_bf16(v1[2], v1[3]);
                    if (ok) *(u32x4*)(rowp + bj * HALF) = w; } }
    }
};

struct EpiPartial { static constexpr bool PERM = true;
    f32x4* P;
    __device__ __forceinline__ void operator()(const Acc& acc, const Unit& u, int wr, int wc, int fr, int fq) const {
        f32x4* p = P + (size_t)u.sub * 16384 + threadIdx.x;
#pragma unroll
        for (int ai = 0; ai < 2; ++ai)
#pragma unroll
            for (int bj = 0; bj < 2; ++bj)
#pragma unroll
                for (int m = 0; m < 4; ++m)
#pragma unroll
                    for (int n = 0; n < 2; ++n) p[(((ai * 2 + bj) * 4 + m) * 2 + n) * 512] = acc[ai][bj][m][n];
    }
};
template <class Epi, class Sched, bool ALIGN_EPI, bool GATHER = false>
__device__ __forceinline__ void gemm_phase(LAS unsigned char* lds, const char* Abase, const char* Bbase, int K, int lda, int ldb, const Sched& S, const Epi& E, int dry = 0, const int* rowmap = nullptr) {
    const int tid = threadIdx.x, wid = __builtin_amdgcn_readfirstlane(tid >> 6), lane = tid & 63, wr = wid >> 2, wc = wid & 3, fr = lane & 15, fq = lane >> 4;
    const int nt = K / BK;
    unsigned voffA[2], voffB[2]; int gR[2], gC[2];
#pragma unroll
    for (int i = 0; i < 2; ++i) { int R, C; stage_rc(tid * 16 + i * 8192, R, C); const int Rb = Epi::PERM ? ((R & ~31) + perm32(R & 31)) : R;
        voffA[i] = (unsigned)(R * lda + C * 2); voffB[i] = (unsigned)(Rb * ldb + C * 2); gR[i] = R; gC[i] = C * 2; }
    unsigned goff[2][2], gnx[2][2];
    LAS unsigned short* tokl = (LAS unsigned short*)(lds + 131072);
    if constexpr (GATHER) {
        for (int i = 0; i < 16; ++i) { const int ar = S.arow_of(i); if (ar < 0) break; if (tid < BM) tokl[i * BM + tid] = (unsigned short)rowmap[ar + tid]; }
        asm volatile("s_waitcnt vmcnt(0) lgkmcnt(0)" ::: "memory"); __syncthreads();
#pragma unroll
        for (int h = 0; h < 2; ++h)
#pragma unroll
            for (int i = 0; i < 2; ++i) { goff[h][i] = (unsigned)tokl[h * HALF + gR[i]] * (unsigned)lda + (unsigned)gC[i]; gnx[h][i] = goff[h][i]; }
    }
    const size_t kstep = (size_t)(BK * 2);
    const size_t hstepA = (size_t)HALF * lda, hstepB = (size_t)HALF * ldb;
    const unsigned ldsw = (unsigned)wid * 1024u;
    const int aoff = lds_byte(wr * 64 + fr, fq * 8), boff = lds_byte(wc * 32 + fr, fq * 8);
#define PG8_SA(b, h) (((b) * 2 + (h)) * HTB)
#define PG8_SB(b, h) ((4 + (b) * 2 + (h)) * HTB)
#define PG8_STAGE(bufoff, gbase, voff) do { _Pragma("unroll") for (int _i = 0; _i < 2; ++_i) \
        __builtin_amdgcn_global_load_lds((const unsigned*)((const char*)(gbase) + (voff)[_i]), (LAS unsigned*)(lds + (bufoff) + ldsw + _i * 8192), 16, 0, 0); } while (0)
#define PG8_STAGE_A(bufoff, gbase, h) do { if constexpr (GATHER) PG8_STAGE(bufoff, gbase, goff[h]); else PG8_STAGE(bufoff, (gbase) + (h) * hstepA, voffA); } while (0)
#define PG8_LDA(dst, b, h) do { _Pragma("unroll") for (int m = 0; m < 4; ++m) _Pragma("unroll") for (int k = 0; k < 2; ++k) dst[m][k] = *(const LAS bf16x8*)(lds + PG8_SA(b, h) + aoff + m * 2048 + k * 1024); } while (0)
#define PG8_LDB(dst, b, h) do { _Pragma("unroll") for (int n = 0; n < 2; ++n) _Pragma("unroll") for (int k = 0; k < 2; ++k) dst[n][k] = *(const LAS bf16x8*)(lds + PG8_SB(b, h) + boff + n * 2048 + k * 1024); } while (0)
#define PG8_MMA(ai, bj, At, Bt) do { __builtin_amdgcn_s_setprio(1); _Pragma("unroll") for (int m = 0; m < 4; ++m) _Pragma("unroll") for (int n = 0; n < 2; ++n) _Pragma("unroll") for (int k = 0; k < 2; ++k) \
        acc[ai][bj][m][n] = __builtin_amdgcn_mfma_f32_16x16x32_bf16(Bt[n][k], At[m][k], acc[ai][bj][m][n], 0, 0, 0); __builtin_amdgcn_s_setprio(0); } while (0)
#define PG8_WAIT_V(n) asm volatile("s_waitcnt vmcnt(" #n ")" ::: "memory")
#define PG8_WAIT_L(n) asm volatile("s_waitcnt lgkmcnt(" #n ")" ::: "memory")
#define PG8_BAR __builtin_amdgcn_s_barrier()
#define PG8_SCHED __builtin_amdgcn_sched_barrier(0)
    Unit cur, nxt; int ui = 0;
    if (!S.next(0, cur)) return;
    Acc acc;
#pragma unroll
    for (int a = 0; a < 2; ++a)
#pragma unroll
        for (int b = 0; b < 2; ++b)
#pragma unroll
            for (int m = 0; m < 4; ++m)
#pragma unroll
                for (int n = 0; n < 2; ++n) acc[a][b][m][n] = (f32x4){0.f, 0.f, 0.f, 0.f};
    bf16x8 At[4][2], B0[2][2], B1[2][2];
    const char* cA = Abase + (GATHER ? (size_t)0 : (size_t)cur.arow * lda) + cur.koff; const char* cB = Bbase + (size_t)cur.brow * ldb + cur.koff;
    PG8_STAGE(PG8_SB(0, 0), cB, voffB); PG8_STAGE(PG8_SB(0, 1), cB + hstepB, voffB); PG8_STAGE_A(PG8_SA(0, 0), cA, 0); PG8_STAGE_A(PG8_SA(0, 1), cA, 1);
    if (wr == 1) PG8_BAR;
    PG8_WAIT_V(2); PG8_BAR;
    PG8_STAGE(PG8_SB(1, 0), cB + kstep, voffB); PG8_STAGE_A(PG8_SA(1, 0), cA + kstep, 0); PG8_STAGE(PG8_SB(1, 1), cB + hstepB + kstep, voffB);
    PG8_WAIT_V(6); PG8_BAR;
    for (;;) {
        const bool has_next = S.next(ui + 1, nxt);
        const char* nA = has_next ? Abase + (GATHER ? (size_t)0 : (size_t)nxt.arow * lda) + nxt.koff : cA; const char* nB = has_next ? Bbase + (size_t)nxt.brow * ldb + nxt.koff : cB;
        if constexpr (GATHER) { if (has_next) {
#pragma unroll
            for (int h = 0; h < 2; ++h)
#pragma unroll
                for (int i = 0; i < 2; ++i) gnx[h][i] = (unsigned)tokl[(ui + 1) * BM + h * HALF + gR[i]] * (unsigned)lda + (unsigned)gC[i]; } }
        for (int t = 0; t < nt; t += 2) {
            const bool last = (t == nt - 2);
            const char* a1 = cA + (size_t)(t + 1) * kstep;
            const char* a2 = last ? nA : cA + (size_t)(t + 2) * kstep; const char* b2 = last ? nB : cB + (size_t)(t + 2) * kstep;
            const char* a3 = a2 + kstep; const char* b3 = b2 + kstep;
            PG8_LDB(B0, 0, 0); PG8_LDB(B1, 0, 1); PG8_SCHED; PG8_LDA(At, 0, 0); PG8_STAGE_A(PG8_SA(1, 1), a1, 1);
            if constexpr (GATHER) { if (last) { goff[0][0] = gnx[0][0]; goff[0][1] = gnx[0][1]; goff[1][0] = gnx[1][0]; goff[1][1] = gnx[1][1]; } }
            PG8_WAIT_V(8); PG8_WAIT_L(0); PG8_BAR; PG8_MMA(0, 0, At, B0); PG8_MMA(0, 1, At, B1); PG8_BAR; PG8_SCHED;
            PG8_LDA(At, 0, 1); PG8_STAGE(PG8_SB(0, 0), b2, voffB); PG8_STAGE(PG8_SB(0, 1), b2 + hstepB, voffB); PG8_STAGE_A(PG8_SA(0, 0), a2, 0);
            PG8_WAIT_V(8); PG8_WAIT_L(0); PG8_BAR; PG8_MMA(1, 0, At, B0); PG8_MMA(1, 1, At, B1); PG8_BAR; PG8_SCHED;
            PG8_LDB(B0, 1, 0); PG8_LDB(B1, 1, 1); PG8_SCHED; PG8_LDA(At, 1, 0); PG8_STAGE_A(PG8_SA(0, 1), a2, 1);
            PG8_WAIT_V(8); PG8_WAIT_L(0); PG8_BAR; PG8_MMA(0, 0, At, B0); PG8_MMA(0, 1, At, B1); PG8_BAR; PG8_SCHED;
            PG8_LDA(At, 1, 1); PG8_STAGE(PG8_SB(1, 0), b3, voffB); PG8_STAGE(PG8_SB(1, 1), b3 + hstepB, voffB); PG8_STAGE_A(PG8_SA(1, 0), a3, 0);
            PG8_WAIT_V(8); PG8_WAIT_L(0); PG8_BAR; PG8_MMA(1, 0, At, B0); PG8_MMA(1, 1, At, B1); PG8_BAR; PG8_SCHED;
        }
        if constexpr (ALIGN_EPI) { if (wr == 0) PG8_BAR; }
        if (!dry) E(acc, cur, wr, wc, fr, fq);
        if (!has_next) break;
#pragma unroll
        for (int a = 0; a < 2; ++a)
#pragma unroll
            for (int b = 0; b < 2; ++b)
#pragma unroll
                for (int m = 0; m < 4; ++m)
#pragma unroll
                    for (int n = 0; n < 2; ++n) acc[a][b][m][n] = (f32x4){0.f, 0.f, 0.f, 0.f};
        cur = nxt; cA = nA; cB = nB; ++ui;
        if constexpr (ALIGN_EPI) { if (wr == 1) PG8_BAR; }
    }
    PG8_WAIT_V(0);
    if constexpr (!ALIGN_EPI) { if (wr == 0) PG8_BAR; }
    PG8_BAR;
#undef PG8_SA
#undef PG8_SB
#undef PG8_STAGE
#undef PG8_LDA
#undef PG8_STAGE_A
#undef PG8_LDB
#undef PG8_MMA
#undef PG8_WAIT_V
#undef PG8_WAIT_L
#undef PG8_BAR
#undef PG8_SCHED
}

struct Args {
    const float* in[20]; float* out; unsigned char* ws; int ph_lo, ph_hi; int flags, pad;
};
struct Frame {
    LAS unsigned char* lds; volatile LAS unsigned* MISC; unsigned char* ws; gu32* ctl;
    int tid, lane, wave, vcu, G, dry;
};

template <bool NTS = false> __device__ __forceinline__ void tr_item(const float* W, int N, int k0, int n0, unsigned short* WT, int ldt, int row0, const float* gain, LAS float* scr, int lane) {
    const int r = lane >> 5, c2 = lane & 31;
    f32x2 tv[32];
    const float* wp = W + (size_t)(k0 + r) * N + n0 + 2 * c2;
#pragma unroll
    for (int i = 0; i < 32; ++i) tv[i] = __builtin_nontemporal_load((const f32x2*)(wp + (size_t)(2 * i) * N));
    if (gain) {
#pragma unroll
        for (int i = 0; i < 32; ++i) tv[i] = tv[i] * gain[k0 + 2 * i + r]; }
#pragma unroll
    for (int i = 0; i < 32; ++i) { const int kk = 2 * i + r; scr[kk * 65 + 2 * c2] = tv[i].x; scr[kk * 65 + 2 * c2 + 1] = tv[i].y; }
    LDS_WAIT(); asm volatile("" ::: "memory");
    const int c = lane & 7;
#pragma unroll
    for (int j = 0; j < 8; ++j) { const int n = (lane >> 3) + 8 * j; const LAS float* s = scr + (8 * c) * 65 + n;
        u32x4 o; o.x = cvt_pk_bf16(s[0 * 65], s[1 * 65]); o.y = cvt_pk_bf16(s[2 * 65], s[3 * 65]); o.z = cvt_pk_bf16(s[4 * 65], s[5 * 65]); o.w = cvt_pk_bf16(s[6 * 65], s[7 * 65]);
        if (NTS) __builtin_nontemporal_store(o, (u32x4*)(WT + (size_t)(row0 + n) * ldt + k0 + 8 * c)); else *(u32x4*)(WT + (size_t)(row0 + n) * ldt + k0 + 8 * c) = o; }
    LDS_WAIT(); asm volatile("" ::: "memory");
}
template <bool NTS = false> __device__ __forceinline__ void tr_plain(const float* W, int K, int N, unsigned short* WT, const float* gain, LAS float* scr, int item, int lane) {
    const int nblk = N / 64, kb = item / nblk, nb = item % nblk; tr_item<NTS>(W, N, kb * 64, nb * 64, WT, K, nb * 64, gain, scr, lane);
}
template <bool NTS = false> __device__ __forceinline__ void tr_inter(const float* W, int K, int N, unsigned short* WT, int up, const float* gain, LAS float* scr, int item, int lane) {
    const int nblk = N / 64, kb = item / nblk, nb = item % nblk, n0 = nb * 64; tr_item<NTS>(W, N, kb * 64, n0, WT, K, 256 * (n0 >> 7) + (n0 & 127) + up * 128, gain, scr, lane);
}
__device__ __forceinline__ void xb_row(const float* xrow, unsigned short* orow, u64* ssp, int lane) {
    const f32x4* xr = (const f32x4*)xrow + lane; f32x4 v[4]; float s = 0.f;
#pragma unroll
    for (int j = 0; j < 4; ++j) { v[j] = __builtin_nontemporal_load(xr + 64 * j); s += (v[j].x * v[j].x + v[j].y * v[j].y) + (v[j].z * v[j].z + v[j].w * v[j].w); }
    s = wave_sum(s);
    u32x2* o8 = (u32x2*)orow + lane;
#pragma unroll
    for (int j = 0; j < 4; ++j) { u32x2 w; w.x = cvt_pk_bf16(v[j].x, v[j].y); w.y = cvt_pk_bf16(v[j].z, v[j].w); o8[64 * j] = w; }
    if (lane == 0) *ssp = (u64)(s * SS_SCALE);
}

constexpr int FL_EXPERTS = 1, FL_L0 = 2, FL_QSCALE1 = 4;

__device__ __forceinline__ void p0_prologue(Frame& F, const Args& a) {
    LAS float* scr = (LAS float*)(F.lds + F.wave * 16640);
    const int gw = F.vcu * NWAVES + F.wave, NGW = F.G * NWAVES;
    constexpr int I_IN = 16 * 96, I_OUT = 48 * 16, I_G = 16 * 44, I_D = 44 * 16, I_QKV = 16 * 48, I_O = 16 * 16, I_EG = 16 * 56, I_ED = 56 * 16;
    unsigned char* ws = F.ws;
    if (a.flags & FL_EXPERTS) {
        constexpr int NIT = NE * 2 * I_EG;
        for (int it = gw; it < NIT; it += NGW) {
            const int e = it / (2 * I_EG); int r = it % (2 * I_EG);
            if (r < I_EG) { tr_inter<true>(a.in[17] + (size_t)e * D * EDIM, D, EDIM, (unsigned short*)(ws + WS_WEGU) + (size_t)e * 2 * EDIM * D, 0, nullptr, scr, r, F.lane); continue; } r -= I_EG;
            tr_inter<true>(a.in[18] + (size_t)e * D * EDIM, D, EDIM, (unsigned short*)(ws + WS_WEGU) + (size_t)e * 2 * EDIM * D, 1, nullptr, scr, r, F.lane);
        }
    }
    if (a.flags & FL_L0) {
        constexpr int NIT = I_IN + I_OUT + 2 * I_G + I_D + I_QKV + I_O;
        for (int it = gw; it < NIT; it += NGW) {
            int r = NIT - 1 - it;
            if (r < I_IN) { tr_plain(a.in[4], D, DFF, (unsigned short*)(ws + WS_WIN), a.in[1], scr, r, F.lane); continue; } r -= I_IN;
            if (r < I_OUT) { tr_plain(a.in[8], HALFC, D, (unsigned short*)(ws + WS_WOUT), nullptr, scr, r, F.lane); continue; } r -= I_OUT;
            if (r < I_G) { tr_inter(a.in[9], D, FFN, (unsigned short*)(ws + WS_WGU), 0, a.in[2], scr, r, F.lane); continue; } r -= I_G;
            if (r < I_G) { tr_inter(a.in[10], D, FFN, (unsigned short*)(ws + WS_WGU), 1, a.in[2], scr, r, F.lane); continue; } r -= I_G;
            if (r < I_D) { tr_plain(a.in[11], FFN, D, (unsigned short*)(ws + WS_WD), nullptr, scr, r, F.lane); continue; } r -= I_D;
            if (r < I_QKV) { tr_plain(a.in[12], D, 3 * D, (unsigned short*)(ws + WS_WQKV), a.in[1] + D, scr, r, F.lane); continue; } r -= I_QKV;
            tr_plain(a.in[14], D, D, (unsigned short*)(ws + WS_WO), nullptr, scr, r, F.lane);
        }
        for (int m = gw; m < T; m += NGW) xb_row(a.in[0] + (size_t)m * D, (unsigned short*)(ws + WS_XB) + (size_t)m * D, (u64*)(ws + WS_SS0) + m, F.lane);
    }
}
__device__ __forceinline__ void side_convert_wed(Frame& F, const Args& a, int k, int n) {
    LAS float* scr = (LAS float*)(F.lds + F.wave * 16640);
    constexpr int I_ED = 56 * 16, NIT = NE * I_ED;
    for (int it = k * NWAVES + F.wave; it < NIT; it += n * NWAVES) { const int e = it / I_ED, r = it % I_ED;
        tr_plain<true>(a.in[19] + (size_t)e * EDIM * D, EDIM, D, (unsigned short*)(F.ws + WS_WED) + (size_t)e * D * EDIM, nullptr, scr, r, F.lane); }
}

__device__ __forceinline__ void p9_router(Frame& F, const Args& a) {
    LAS float* rwT = (LAS float*)F.lds;
    LAS int* lcnt = (LAS int*)(F.lds + 32768);
    const float* g = a.in[2] + D;
    { const float* rw = a.in[15];
      for (int i = F.tid; i < D * NE; i += NWAVES * 64) { const int k = i >> 3, e = i & 7; rwT[e * D + k] = rw[i] * g[k]; } }
    if (F.tid < NE) lcnt[F.tid] = 0;
    f32x4 gv[4];
#pragma unroll
    for (int j = 0; j < 4; ++j) gv[j] = ((const f32x4*)g)[F.lane + 64 * j];
    LDS_WAIT(); __syncthreads();
    const float* rb = a.in[16]; const unsigned short* XB = (const unsigned short*)(F.ws + WS_XB); unsigned short* X3N = (unsigned short*)(F.ws + WS_X3N);
    int* wgcnt = (int*)(F.ws + WS_LIST); int* tokslot = (int*)(F.ws + WS_TOKSLOT); float* tokw = (float*)(F.ws + WS_TOKW);
    const int TPW = T / F.G, t0 = F.vcu * TPW;
    for (int t = t0 + F.wave; t < t0 + TPW; t += NWAVES) {
        const u32x2* xr = (const u32x2*)(XB + (size_t)t * D) + F.lane; float lg[NE]; float s = 0.f; f32x4 xv[4];
#pragma unroll
        for (int e = 0; e < NE; ++e) lg[e] = 0.f;
#pragma unroll
        for (int j = 0; j < 4; ++j) { const u32x2 w = xr[64 * j]; const f32x4 x = (f32x4){__uint_as_float(w.x << 16), __uint_as_float(w.x & 0xffff0000u), __uint_as_float(w.y << 16), __uint_as_float(w.y & 0xffff0000u)};
            xv[j] = x; s += (x.x * x.x + x.y * x.y) + (x.z * x.z + x.w * x.w);
#pragma unroll
            for (int e = 0; e < NE; ++e) { const f32x4 wv = *(const LAS f32x4*)(rwT + e * D + 4 * (F.lane + 64 * j)); lg[e] += (x.x * wv.x + x.y * wv.y) + (x.z * wv.z + x.w * wv.w); } }
        s = wave_sum(s); const float r = rsqrtf(s * (1.0f / D) + EPS);
        if (!F.dry) { u32x2* o = (u32x2*)(X3N + (size_t)t * D) + F.lane;
#pragma unroll
            for (int j = 0; j < 4; ++j) { const f32x4 v = xv[j] * gv[j] * r; u32x2 w; w.x = cvt_pk_bf16(v.x, v.y); w.y = cvt_pk_bf16(v.z, v.w); o[64 * j] = w; } }
#pragma unroll
        for (int e = 0; e < NE; ++e) lg[e] = wave_sum(lg[e]) * r + rb[e];
        if (F.lane == 0 && !F.dry) {
            int e1 = 0; float v1 = lg[0];
#pragma unroll
            for (int e = 1; e < NE; ++e) if (lg[e] > v1) { v1 = lg[e]; e1 = e; }
            int e2 = -1; float v2 = -3.0e38f;
#pragma unroll
            for (int e = 0; e < NE; ++e) if (e != e1 && lg[e] > v2) { v2 = lg[e]; e2 = e; }
            const float w2 = 1.0f / (1.0f + __expf(v1 - v2)), w1 = 1.0f - w2;
            const int p1 = __hip_atomic_fetch_add(lcnt + e1, 1, __ATOMIC_RELAXED, __HIP_MEMORY_SCOPE_WORKGROUP), p2 = __hip_atomic_fetch_add(lcnt + e2, 1, __ATOMIC_RELAXED, __HIP_MEMORY_SCOPE_WORKGROUP);
            tokslot[t * 4 + 0] = e1; tokslot[t * 4 + 1] = p1; tokslot[t * 4 + 2] = e2; tokslot[t * 4 + 3] = p2;
            tokw[t * 2 + 0] = w1; tokw[t * 2 + 1] = w2;
        }
    }
    LDS_WAIT(); __syncthreads();
    if (F.tid < NE && !F.dry) wgcnt[F.vcu * NE + F.tid] = lcnt[F.tid];
}
__device__ __forceinline__ int slot_base(const int* cnt, int e) {
    int o = 0;
#pragma unroll
    for (int j = 0; j < NE; ++j) { const int c = ((cnt[j] + 255) >> 8) << 8; o += (j < e) ? c : 0; }
    return o;
}
__device__ __forceinline__ void p9b_gather(Frame& F, const Args& a) {
    int* cnt = (int*)(F.ctl + CW_CNT); const int* wgcnt = (const int*)(F.ws + WS_LIST); int* tokslot = (int*)(F.ws + WS_TOKSLOT); const float* tokw = (const float*)(F.ws + WS_TOKW);
    float* slotw = (float*)(F.ws + WS_SLOTW); int* slot_tok = (int*)(F.ws + WS_SLOTTOK);
    LAS int* tot = (LAS int*)F.lds; LAS int* mine = tot + NE; LAS int* sbase = mine + NE; LAS int* gb = sbase + NE;
    __syncthreads();
    {
        const int e = F.wave; int v[4]; int before = 0, total = 0;
#pragma unroll
        for (int j = 0; j < 4; ++j) { const int w = 4 * F.lane + j; v[j] = w < F.G ? wgcnt[w * NE + e] : 0; }
        int mysum = v[0] + v[1] + v[2] + v[3];
        int incl = mysum;
#pragma unroll
        for (int o = 1; o < 64; o <<= 1) { const int n = __shfl_up(incl, o); if (F.lane >= o) incl += n; }
        total = __shfl(incl, 63);
        const int wl = F.vcu >> 2, wj = F.vcu & 3;
        int excl = incl - mysum; int part = excl + (wj > 0 ? v[0] : 0) + (wj > 1 ? v[1] : 0) + (wj > 2 ? v[2] : 0);
        before = __shfl(part, wl);
        if (F.lane == 0) { tot[e] = total; mine[e] = before; }
    }
    LDS_WAIT(); __syncthreads();
    if (F.tid < NE) { int o = 0;
#pragma unroll
        for (int j = 0; j < NE; ++j) { const int c = ((tot[j] + 255) >> 8) << 8; o += (j < F.tid) ? c : 0; }
        sbase[F.tid] = o + mine[F.tid]; gb[F.tid] = o;
        if (blockIdx.x == 0 && !F.dry) cnt[F.tid] = tot[F.tid]; }
    LDS_WAIT(); __syncthreads();
    if (blockIdx.x == 0 && !F.dry) {
#pragma unroll
        for (int e = 0; e < NE; ++e) { const int te = tot[e], n = (((te + 255) >> 8) << 8) - te; if (F.tid < n) { slot_tok[gb[e] + te + F.tid] = 0; slotw[gb[e] + te + F.tid] = 0.f; } } }
    const int TPW = T / F.G, t0 = F.vcu * TPW;
    for (int t = t0 + F.tid; t < t0 + TPW; t += NWAVES * 64) {
        const int e1 = tokslot[t * 4], p1 = tokslot[t * 4 + 1], e2 = tokslot[t * 4 + 2], p2 = tokslot[t * 4 + 3];
        const int s1 = sbase[e1] + p1, s2 = sbase[e2] + p2;
        if (!F.dry) { slot_tok[s1] = t; slot_tok[s2] = t; slotw[s1] = tokw[t * 2]; slotw[s2] = tokw[t * 2 + 1]; tokslot[t * 4 + 1] = s1; tokslot[t * 4 + 3] = s2; }
    }
}
__device__ __forceinline__ void p12_final(Frame& F, const Args& a) {
    const int* cnt = (const int*)(F.ctl + CW_CNT); const int* tokslot = (const int*)(F.ws + WS_TOKSLOT); const unsigned short* Y = (const unsigned short*)(F.ws + WS_Y);
    const f32x4* gr = (const f32x4*)a.in[3] + F.lane;
    const int gw = F.vcu * NWAVES + F.wave, NGW = F.G * NWAVES;
    for (int t = gw; t < T; t += NGW) {
        const size_t s1 = (size_t)tokslot[t * 4 + 1], s2 = (size_t)tokslot[t * 4 + 3];
        f32x4* xr = (f32x4*)(a.out + (size_t)t * D) + F.lane; const u32x2* xb = (const u32x2*)((const unsigned short*)(F.ws + WS_XB) + (size_t)t * D) + F.lane; const u32x2* y1 = (const u32x2*)(Y + s1 * D) + F.lane; const u32x2* y2 = (const u32x2*)(Y + s2 * D) + F.lane;
        f32x4 v[4]; float s = 0.f;
#pragma unroll
        for (int j = 0; j < 4; ++j) { const u32x2 a1 = y1[64 * j], a2 = y2[64 * j], xw = xb[64 * j]; f32x4 x = (f32x4){__uint_as_float(xw.x << 16), __uint_as_float(xw.x & 0xffff0000u), __uint_as_float(xw.y << 16), __uint_as_float(xw.y & 0xffff0000u)};
            x.x += __uint_as_float(a1.x << 16) + __uint_as_float(a2.x << 16); x.y += __uint_as_float(a1.x & 0xffff0000u) + __uint_as_float(a2.x & 0xffff0000u);
            x.z += __uint_as_float(a1.y << 16) + __uint_as_float(a2.y << 16); x.w += __uint_as_float(a1.y & 0xffff0000u) + __uint_as_float(a2.y & 0xffff0000u);
            v[j] = x; s += (x.x * x.x + x.y * x.y) + (x.z * x.z + x.w * x.w); }
        const float r = rsqrtf(wave_sum(s) * (1.0f / D) + EPS);
#pragma unroll
        for (int j = 0; j < 4; ++j) if (!F.dry) xr[64 * j] = v[j] * gr[64 * j] * r;
    }
}


typedef short v4i16_t __attribute__((ext_vector_type(4)));
__device__ __forceinline__ s16x4 lds_tr(LAS unsigned char* p) { return __builtin_bit_cast(s16x4, __builtin_amdgcn_ds_read_tr16_b64_v4i16((LAS v4i16_t*)p)); }
__device__ __forceinline__ void p2_gating(Frame& F, const Args& a) {
    constexpr int VS = 832, WSP = 272;
    LAS unsigned char* Vl = F.lds; LAS unsigned char* Wl = F.lds + 128 * VS; LAS float* rsl = (LAS float*)(F.lds + 128 * VS + 128 * WSP);
    unsigned short* Z = (unsigned short*)(F.ws + WS_Z); const u64* ssv = (const u64*)(F.ws + WS_SSV);
    const float* gain = a.in[5]; const float* wsp = a.in[6]; const float* bsp = a.in[7];
    const int tid = F.tid, lane = F.lane, wave = F.wave, th = wave >> 2, wc = wave & 3, fr = lane & 15, fq = lane >> 4;
    constexpr int NU = (T / GBLK) * GRP;
    const int per = (NU % F.G == 0) ? NU / F.G : 0;
    const int nun = per ? per : (NU - F.vcu + F.G - 1) / F.G;
#define P2_UNIT(i) (per ? F.vcu * per + (i) : (i) * F.G + F.vcu)
    u32x4 vr[12]; float rsv = 0.f;
#define P2_LOADV(un) do { const int blk_ = (un) >> 3, g_ = (un) & 7; _Pragma("unroll") for (int j = 0; j < 12; ++j) { const int id = tid + 512 * j, row = id / 48, ch = id % 48; \
        vr[j] = *(const u32x4*)(Z + (size_t)(blk_ * GBLK + row) * DFF + HALFC + g_ * GDIM + ch * 8); } if (tid < GBLK) rsv = rs_of(ssv, blk_ * GBLK + tid, 1.0f / HALFC); } while (0)
    if (nun <= 0) return;
    P2_LOADV(P2_UNIT(0));
    for (int i = 0; i < nun; ++i) {
        const int un = P2_UNIT(i), blk = un >> 3, g = un & 7; const bool more = i + 1 < nun;
        const int cb = g * GDIM + wc * 96 + 8 * fq;
        u32x4 uu[3][4]; float bb[4];
#pragma unroll
        for (int m = 0; m < 4; ++m) { const int t = 64 * th + 16 * m + fr; bb[m] = bsp[g * GBLK + t];
#pragma unroll
            for (int p = 0; p < 3; ++p) uu[p][m] = *(const u32x4*)(Z + (size_t)(blk * GBLK + t) * DFF + cb + 32 * p); }
#pragma unroll
        for (int j = 0; j < 12; ++j) { const int id = tid + 512 * j, row = id / 48, ch = id % 48; *(LAS u32x4*)(Vl + row * VS + ch * 16) = vr[j]; }
        if (tid < GBLK) rsl[tid] = rsv;
        LDS_WAIT(); __syncthreads();
        { const int t = tid >> 2, s0 = (tid & 3) * 32; const f32x4* wrow = (const f32x4*)(wsp + ((size_t)g * GBLK + t) * GBLK + s0);
#pragma unroll
            for (int j = 0; j < 4; ++j) { const f32x4 w0 = wrow[2 * j], w1 = wrow[2 * j + 1]; const f32x4 r0 = *(const LAS f32x4*)(rsl + s0 + 8 * j), r1 = *(const LAS f32x4*)(rsl + s0 + 8 * j + 4);
                u32x4 o; o.x = cvt_pk_bf16(w0.x * r0.x, w0.y * r0.y); o.y = cvt_pk_bf16(w0.z * r0.z, w0.w * r0.w); o.z = cvt_pk_bf16(w1.x * r1.x, w1.y * r1.y); o.w = cvt_pk_bf16(w1.z * r1.z, w1.w * r1.w);
                *(LAS u32x4*)(Wl + t * WSP + (s0 + 8 * j) * 2) = o; } }
        LDS_WAIT(); __syncthreads();
        if (more) P2_LOADV(P2_UNIT(i + 1));
        const int nks = th ? 4 : 2;
        LAS unsigned char* vbase = Vl + (8 * fq + (fr >> 2)) * VS + (wc * 96 + 8 * (fr & 3)) * 2;
        LAS unsigned char* wbase = Wl + (64 * th + fr) * WSP + (8 * fq) * 2;
#pragma unroll
        for (int p = 0; p < 3; ++p) {
            const int c0 = cb + 32 * p; const f32x4 ga = *(const f32x4*)(gain + c0), gb = *(const f32x4*)(gain + c0 + 4);
            f32x4 acc[4][2];
#pragma unroll
            for (int m = 0; m < 4; ++m) { acc[m][0] = (f32x4){0.f, 0.f, 0.f, 0.f}; acc[m][1] = (f32x4){0.f, 0.f, 0.f, 0.f}; }
            for (int ks = 0; ks < nks; ++ks) {
                bf16x8 wf[4], vf[2];
#pragma unroll
                for (int m = 0; m < 4; ++m) wf[m] = *(const LAS bf16x8*)(wbase + (16 * m) * WSP + (32 * ks) * 2);
#pragma unroll
                for (int n = 0; n < 2; ++n) { const s16x4 lo = lds_tr(vbase + (32 * ks) * VS + p * 64 + n * 8), hi = lds_tr(vbase + (32 * ks + 4) * VS + p * 64 + n * 8);
                    vf[n] = (bf16x8){lo[0], lo[1], lo[2], lo[3], hi[0], hi[1], hi[2], hi[3]}; }
#pragma unroll
                for (int m = 0; m < 4; ++m)
#pragma unroll
                    for (int n = 0; n < 2; ++n) acc[m][n] = __builtin_amdgcn_mfma_f32_16x16x32_bf16(vf[n], wf[m], acc[m][n], 0, 0, 0);
            }
#pragma unroll
            for (int m = 0; m < 4; ++m) { const int t = 64 * th + 16 * m + fr; const f32x4 s0 = acc[m][0] * ga + bb[m], s1 = acc[m][1] * gb + bb[m]; const u32x4 uv = uu[p][m];
                u32x4 o;
                o.x = cvt_pk_bf16(__uint_as_float(uv.x << 16) * s0[0], __uint_as_float(uv.x & 0xffff0000u) * s0[1]); o.y = cvt_pk_bf16(__uint_as_float(uv.y << 16) * s0[2], __uint_as_float(uv.y & 0xffff0000u) * s0[3]);
                o.z = cvt_pk_bf16(__uint_as_float(uv.z << 16) * s1[0], __uint_as_float(uv.z & 0xffff0000u) * s1[1]); o.w = cvt_pk_bf16(__uint_as_float(uv.w << 16) * s1[2], __uint_as_float(uv.w & 0xffff0000u) * s1[3]);
                if (!F.dry) *(u32x4*)(Z + (size_t)(blk * GBLK + t) * DFF + c0) = o; }
        }
        __syncthreads();
    }
#undef P2_UNIT
#undef P2_LOADV
}

__device__ __forceinline__ void p7_attention(Frame& F, const Args& a) {
    constexpr int KS = 144;
    constexpr int SLOT = 64 * KS;
    LAS unsigned char* Kl = F.lds; LAS unsigned char* Vl = F.lds + 2 * SLOT; LAS float* bl = (LAS float*)(F.lds + 4 * SLOT);
    const unsigned short* Qg = (const unsigned short*)(F.ws + WS_Q); const unsigned short* Kg = (const unsigned short*)(F.ws + WS_K); const unsigned short* Vg = (const unsigned short*)(F.ws + WS_V);
    unsigned short* Og = (unsigned short*)(F.ws + WS_O); const float* rel = a.in[13];
    const int tid = F.tid, lane = F.lane, w = F.wave, cw = w >> 1, fr = lane & 15, fq = lane >> 4;
    constexpr int NU = NB * NH * (SEQ / 256);
    const int lrow = tid >> 3, lch = tid & 7;
    for (int un = F.vcu; un < NU; un += F.G) {
        int qb, h, b;
        if (F.G == 256) { const int x = F.vcu >> 5, j = (F.vcu & 31) + 32 * (un >> 8); b = x >> 1; qb = 8 * (x & 1) + (j & 7); h = j >> 3; }
        else { qb = un & 15; h = (un >> 4) & 15; b = un >> 8; }
        const size_t rowb = (size_t)b * SEQ;
        __syncthreads();
        if (tid < 384) bl[tid] = rel[h * RELSZ + (tid < RELSZ ? tid : RELSZ - 1)] * LOG2E;
        bf16x8 qf[2][2];
#pragma unroll
        for (int qt = 0; qt < 2; ++qt)
#pragma unroll
            for (int ks = 0; ks < 2; ++ks) qf[qt][ks] = *(const bf16x8*)(Qg + (rowb + qb * 256 + 32 * w + 16 * qt + fr) * D + h * HD + 32 * ks + 8 * fq);
        f32x4 o[4][2];
#pragma unroll
        for (int dt = 0; dt < 4; ++dt) { o[dt][0] = (f32x4){0.f, 0.f, 0.f, 0.f}; o[dt][1] = (f32x4){0.f, 0.f, 0.f, 0.f}; }
        float mrun[2] = {-1e30f, -1e30f}, lrun[2] = {0.f, 0.f};
        const int jt0 = (4 * qb - 8 < 0) ? (8 - 4 * qb) : 0;
        u32x4 kreg, vreg;
        { const size_t krow = rowb + (size_t)(4 * qb - 8 + jt0) * 64 + lrow; kreg = *(const u32x4*)(Kg + krow * D + h * HD + lch * 8); vreg = *(const u32x4*)(Vg + krow * D + h * HD + lch * 8); }
        *(LAS u32x4*)(Kl + (jt0 & 1) * SLOT + lrow * KS + lch * 16) = kreg; *(LAS u32x4*)(Vl + (jt0 & 1) * SLOT + lrow * KS + lch * 16) = vreg;
        LDS_WAIT(); __syncthreads();
        for (int jt = jt0; jt < 12; ++jt) {
            const bool more = jt + 1 < 12;
            if (more) { const size_t krow = rowb + (size_t)(4 * qb - 8 + jt + 1) * 64 + lrow; kreg = *(const u32x4*)(Kg + krow * D + h * HD + lch * 8); vreg = *(const u32x4*)(Vg + krow * D + h * HD + lch * 8); }
            if (jt >= cw && jt <= cw + 8) {
                LAS unsigned char* Ks_ = Kl + (jt & 1) * SLOT; LAS unsigned char* Vs_ = Vl + (jt & 1) * SLOT;
                f32x4 sc[4][2];
#pragma unroll
                for (int it = 0; it < 4; ++it) { sc[it][0] = (f32x4){0.f, 0.f, 0.f, 0.f}; sc[it][1] = (f32x4){0.f, 0.f, 0.f, 0.f}; }
#pragma unroll
                for (int ks = 0; ks < 2; ++ks)
#pragma unroll
                    for (int it = 0; it < 4; ++it) { const bf16x8 kf = *(const LAS bf16x8*)(Ks_ + (16 * it + fr) * KS + (32 * ks + 8 * fq) * 2);
                        sc[it][0] = __builtin_amdgcn_mfma_f32_16x16x32_bf16(kf, qf[0][ks], sc[it][0], 0, 0, 0);
                        sc[it][1] = __builtin_amdgcn_mfma_f32_16x16x32_bf16(kf, qf[1][ks], sc[it][1], 0, 0, 0); }
                const int dchunk = cw + 8 - jt;
                if (dchunk <= 4) {
#pragma unroll
                    for (int qt = 0; qt < 2; ++qt) { const int qloc = 32 * (w & 1) + 16 * qt + fr;
#pragma unroll
                        for (int it = 0; it < 4; ++it)
#pragma unroll
                            for (int r = 0; r < 4; ++r) sc[it][qt][r] += bl[64 * dchunk + qloc - 4 * fq + (CHUNK - 1) - (16 * it + r)]; }
                } else { const float bc = bl[RELSZ - 1];
#pragma unroll
                    for (int it = 0; it < 4; ++it) { sc[it][0] = sc[it][0] + bc; sc[it][1] = sc[it][1] + bc; } }
                bf16x8 pf[2][2];
#pragma unroll
                for (int qt = 0; qt < 2; ++qt) {
                    float mx = sc[0][qt][0];
#pragma unroll
                    for (int it = 0; it < 4; ++it)
#pragma unroll
                        for (int r = 0; r < 4; ++r) mx = fmaxf(mx, sc[it][qt][r]);
                    mx = fmaxf(mx, __shfl_xor(mx, 16)); mx = fmaxf(mx, __shfl_xor(mx, 32));
                    const float mn = fmaxf(mrun[qt], mx), corr = __builtin_amdgcn_exp2f(mrun[qt] - mn); mrun[qt] = mn;
                    float ps = 0.f; float p[4][4];
#pragma unroll
                    for (int it = 0; it < 4; ++it)
#pragma unroll
                        for (int r = 0; r < 4; ++r) { p[it][r] = __builtin_amdgcn_exp2f(sc[it][qt][r] - mn); ps += p[it][r]; }
                    lrun[qt] = lrun[qt] * corr + ps;
                    if (__builtin_amdgcn_ballot_w64(corr != 1.0f)) {
#pragma unroll
                        for (int dt = 0; dt < 4; ++dt) o[dt][qt] = o[dt][qt] * corr; }
#pragma unroll
                    for (int kk = 0; kk < 2; ++kk) { u32x4 pk; pk.x = cvt_pk_bf16(p[2 * kk][0], p[2 * kk][1]); pk.y = cvt_pk_bf16(p[2 * kk][2], p[2 * kk][3]); pk.z = cvt_pk_bf16(p[2 * kk + 1][0], p[2 * kk + 1][1]); pk.w = cvt_pk_bf16(p[2 * kk + 1][2], p[2 * kk + 1][3]);
                        pf[kk][qt] = __builtin_bit_cast(bf16x8, pk); }
                }
                LAS unsigned char* vb = Vs_ + (4 * fq + (fr >> 2)) * KS + (4 * (fr & 3)) * 2;
#pragma unroll
                for (int kk = 0; kk < 2; ++kk)
#pragma unroll
                    for (int dt = 0; dt < 4; ++dt) { const s16x4 lo = lds_tr(vb + (32 * kk) * KS + dt * 32), hi = lds_tr(vb + (32 * kk + 16) * KS + dt * 32);
                        const bf16x8 vf = (bf16x8){lo[0], lo[1], lo[2], lo[3], hi[0], hi[1], hi[2], hi[3]};
                        o[dt][0] = __builtin_amdgcn_mfma_f32_16x16x32_bf16(vf, pf[kk][0], o[dt][0], 0, 0, 0);
                        o[dt][1] = __builtin_amdgcn_mfma_f32_16x16x32_bf16(vf, pf[kk][1], o[dt][1], 0, 0, 0); }
            }
            if (more) { *(LAS u32x4*)(Kl + ((jt + 1) & 1) * SLOT + lrow * KS + lch * 16) = kreg; *(LAS u32x4*)(Vl + ((jt + 1) & 1) * SLOT + lrow * KS + lch * 16) = vreg; }
            LDS_WAIT(); __syncthreads();
        }
#pragma unroll
        for (int qt = 0; qt < 2; ++qt) { float l = lrun[qt]; l += __shfl_xor(l, 16); l += __shfl_xor(l, 32); const float inv = 1.0f / l;
            unsigned short* orow = Og + (rowb + qb * 256 + 32 * w + 16 * qt + fr) * D + h * HD + 4 * fq;
#pragma unroll
            for (int dt = 0; dt < 4; ++dt) { const f32x4 v = o[dt][qt] * inv; u32x2 wv; wv.x = cvt_pk_bf16(v[0], v[1]); wv.y = cvt_pk_bf16(v[2], v[3]); *(u32x2*)(orow + 16 * dt) = wv; } }
    }
}


__device__ __forceinline__ void p12c_combine(Frame& F, const MoeOrder& MO, int L0, int R, int S) {
    const f32x4* P = (const f32x4*)(F.ws + WS_PART); unsigned short* Y = (unsigned short*)(F.ws + WS_Y); const float* slotw = (const float*)(F.ws + WS_SLOTW);
    const int j = F.vcu; if (j >= R * S) return;
    const int q = j / S, part = j % S, C = (16384 + S - 1) / S;
    Unit u; MO.fill(L0 + q, u);
    const int c1 = (part + 1) * C < 16384 ? (part + 1) * C : 16384;
    for (int cell = part * C + F.tid; cell < c1; cell += NWAVES * 64) {
        const int idx = cell >> 9, tid = cell & 511, n = idx & 1, m = (idx >> 1) & 3, bj = (idx >> 3) & 1, ai = idx >> 4;
        const int wid = tid >> 6, lane = tid & 63, wr = wid >> 2, wc = wid & 3, fr = lane & 15, fq = lane >> 4;
        f32x4 a = (f32x4){0.f, 0.f, 0.f, 0.f};
        for (int ks = 0; ks < S; ++ks) a = a + P[(size_t)(q * S + ks) * 16384 + cell];
        const int lrow = ai * HALF + wr * 64 + m * 16 + fr, row = u.pm * BM + lrow, col = u.pn * BM + bj * HALF + wc * 32 + 8 * fq + 4 * n;
        if (lrow < u.rows) { const float r = slotw[row]; u32x2 w; w.x = cvt_pk_bf16(a[0] * r, a[1] * r); w.y = cvt_pk_bf16(a[2] * r, a[3] * r); *(u32x2*)(Y + (size_t)row * D + col) = w; }
    }
}
__device__ __forceinline__ int split_of(int R, int G) { return R * 14 <= G ? 14 : R * 7 <= G ? 7 : R * 4 <= G ? 4 : R * 2 <= G ? 2 : 1; }

constexpr int NPH = 15;
__global__ void __launch_bounds__(NWAVES * 64, 2) fwd(Args args) {
    extern __shared__ __attribute__((aligned(16))) unsigned char lds_raw[];
    Frame F; F.lds = (LAS unsigned char*)lds_raw; F.MISC = (volatile LAS unsigned*)(F.lds + MISC_OFF);
    F.tid = threadIdx.x; F.lane = F.tid & 63; F.wave = __builtin_amdgcn_readfirstlane(F.tid >> 6);
    F.G = gridDim.x; { const int bx = blockIdx.x; F.vcu = (F.G % 8 == 0) ? (bx % 8) * (F.G / 8) + bx / 8 : bx; }
    F.ws = args.ws; F.ctl = (gu32*)(args.ws + WS_CTL); F.dry = 0;
    unsigned char* ws = args.ws;
    for (int u = F.tid; u < (LDS_BYTES - LDSCTL_OFF) / 4; u += NWAVES * 64) ((LAS unsigned*)(F.lds + LDSCTL_OFF))[u] = 0u;
    __syncthreads();
    const int lo = args.ph_lo, hi = args.ph_hi;
    XcdBarrier bar; bar.bar = (unsigned*)(F.ctl + CW_BAR); bar.x = 0; bar.st = nullptr;
    if (hi - lo > 1) bar = xcd_barrier_post((unsigned*)(F.ctl + CW_BAR), F.MISC + 8);
#define IN(k) (lo <= (k) && (k) < hi)
    unsigned long long ts_t0 = 0, ts_acc = 0;
#define TS_BEGIN(k) do { if ((PROBE_TS >> (k)) & 1) ts_t0 = __builtin_amdgcn_s_memrealtime(); } while (0)
#define TS_END(k) do { if ((PROBE_TS >> (k)) & 1) ts_acc += __builtin_amdgcn_s_memrealtime() - ts_t0; } while (0)
#define SEAM(k) do { if (IN(k) && IN((k) + 1)) xcd_barrier(bar); } while (0)
    const int bx = (int)blockIdx.x;
    unsigned short* XB = (unsigned short*)(ws + WS_XB);
    u64* ss0 = (u64*)(ws + WS_SS0); u64* ssv = (u64*)(ws + WS_SSV); u64* ss1 = (u64*)(ws + WS_SS1); u64* ss2 = (u64*)(ws + WS_SS2);

    TS_BEGIN(0);
    if (IN(0)) {
#if PROBE_REP == 0
        p0_prologue(F, args);
#endif
        p0_prologue(F, args); } SEAM(0); TS_END(0);
    TS_BEGIN(1);
    if (IN(1)) {
        DenseOrder S{T / BM, DFF / BM, F.G, bx}; EpiGeluZ E{(unsigned short*)(ws + WS_Z), ss0, ssv};
#if PROBE_REP == 1
        gemm_phase<EpiGeluZ, DenseOrder, true>(F.lds, (const char*)XB, (const char*)(ws + WS_WIN), D, D * 2, D * 2, S, E, (args.flags >> 16) & 1);
#endif
        gemm_phase<EpiGeluZ, DenseOrder, true>(F.lds, (const char*)XB, (const char*)(ws + WS_WIN), D, D * 2, D * 2, S, E);
    } SEAM(1); TS_END(1);
    TS_BEGIN(2);
    if (IN(2)) {
#if PROBE_REP == 2
        F.dry = (args.flags >> 16) & 1; p2_gating(F, args); F.dry = 0;
#endif
        p2_gating(F, args); } SEAM(2); TS_END(2);
    TS_BEGIN(3);
    if (IN(3)) {
        DenseOrder S{T / BM, D / BM, F.G, bx}; EpiResid<false> E{nullptr, XB, ss1, nullptr};
#if PROBE_REP == 3
        gemm_phase<EpiResid<false>, DenseOrder, false>(F.lds, (const char*)(ws + WS_Z), (const char*)(ws + WS_WOUT), HALFC, DFF * 2, HALFC * 2, S, E, (args.flags >> 16) & 1);
#endif
        gemm_phase<EpiResid<false>, DenseOrder, false>(F.lds, (const char*)(ws + WS_Z), (const char*)(ws + WS_WOUT), HALFC, DFF * 2, HALFC * 2, S, E);
    } SEAM(3); TS_END(3);
    TS_BEGIN(4);
    if (IN(4)) {
        DenseOrder S{T / BM, 2 * FFN / BM, F.G, bx}; EpiSwigluT<true> E{(unsigned short*)(ws + WS_H), FFN, ss1};
#if PROBE_REP == 4
        gemm_phase<EpiSwigluT<true>, DenseOrder, true>(F.lds, (const char*)XB, (const char*)(ws + WS_WGU), D, D * 2, D * 2, S, E, (args.flags >> 16) & 1);
#endif
        gemm_phase<EpiSwigluT<true>, DenseOrder, true>(F.lds, (const char*)XB, (const char*)(ws + WS_WGU), D, D * 2, D * 2, S, E);
        { const int rem = ((T / BM) * (2 * FFN / BM)) % F.G;
          if (rem == 0) side_convert_wed(F, args, bx, F.G); else if (bx >= rem) side_convert_wed(F, args, bx - rem, F.G - rem); }
    } SEAM(4); TS_END(4);
    TS_BEGIN(5);
    if (IN(5)) {
        DenseOrder S{T / BM, D / BM, F.G, bx}; EpiResid<false> E{nullptr, XB, ss2, nullptr};
#if PROBE_REP == 5
        gemm_phase<EpiResid<false>, DenseOrder, false>(F.lds, (const char*)(ws + WS_H), (const char*)(ws + WS_WD), FFN, FFN * 2, FFN * 2, S, E, (args.flags >> 16) & 1);
#endif
        gemm_phase<EpiResid<false>, DenseOrder, false>(F.lds, (const char*)(ws + WS_H), (const char*)(ws + WS_WD), FFN, FFN * 2, FFN * 2, S, E);
    } SEAM(5); TS_END(5);
    TS_BEGIN(6);
    if (IN(6)) {
        DenseOrder S{T / BM, 3 * D / BM, F.G, bx}; EpiQKV E{(unsigned short*)(ws + WS_Q), (size_t)(WS_K - WS_Q) / 2, ss2, (args.flags & FL_QSCALE1) ? 1.0f : 0.125f * LOG2E};
#if PROBE_REP == 6
        gemm_phase<EpiQKV, DenseOrder, true>(F.lds, (const char*)XB, (const char*)(ws + WS_WQKV), D, D * 2, D * 2, S, E, (args.flags >> 16) & 1);
#endif
        gemm_phase<EpiQKV, DenseOrder, true>(F.lds, (const char*)XB, (const char*)(ws + WS_WQKV), D, D * 2, D * 2, S, E);
    } SEAM(6); TS_END(6);
    TS_BEGIN(7);
    if (IN(7)) {
#if PROBE_REP == 7
        p7_attention(F, args);
#endif
        p7_attention(F, args); } SEAM(7); TS_END(7);
    TS_BEGIN(8);
    if (IN(8)) {
        DenseOrder S{T / BM, D / BM, F.G, bx}; EpiResid<false> E{nullptr, XB, nullptr, nullptr};
#if PROBE_REP == 8
        gemm_phase<EpiResid<false>, DenseOrder, false>(F.lds, (const char*)(ws + WS_O), (const char*)(ws + WS_WO), D, D * 2, D * 2, S, E, (args.flags >> 16) & 1);
#endif
        gemm_phase<EpiResid<false>, DenseOrder, false>(F.lds, (const char*)(ws + WS_O), (const char*)(ws + WS_WO), D, D * 2, D * 2, S, E);
    } SEAM(8); TS_END(8);
    TS_BEGIN(9);
    if (IN(9)) {
#if PROBE_REP == 9
        F.dry = 1; p9_router(F, args); F.dry = 0;
#endif
        p9_router(F, args); } SEAM(9); TS_END(9);
    TS_BEGIN(10);
    if (IN(10)) {
#if PROBE_REP == 9
        F.dry = 1; p9b_gather(F, args); F.dry = 0;
#endif
        p9b_gather(F, args); } SEAM(10); TS_END(10);
    TS_BEGIN(11);
    if (IN(11)) {
        MoeOrder S; S.init((const int*)(F.ctl + CW_CNT), 2 * EDIM / BM, F.G, bx, 2 * EDIM); EpiSwigluT<false> E{(unsigned short*)(ws + WS_HM), EDIM, nullptr};
#if PROBE_REP == 11
        gemm_phase<EpiSwigluT<false>, MoeOrder, true, true>(F.lds, (const char*)(ws + WS_X3N), (const char*)(ws + WS_WEGU), D, D * 2, D * 2, S, E, (args.flags >> 16) & 1, (const int*)(ws + WS_SLOTTOK));
#endif
        gemm_phase<EpiSwigluT<false>, MoeOrder, true, true>(F.lds, (const char*)(ws + WS_X3N), (const char*)(ws + WS_WEGU), D, D * 2, D * 2, S, E, 0, (const int*)(ws + WS_SLOTTOK));
    } SEAM(11); TS_END(11);
    TS_BEGIN(12);
    if (IN(12)) {
        MoeOrder S; S.init((const int*)(F.ctl + CW_CNT), D / BM, F.G, bx, D); S.rev = 1; EpiMoe2 E{(unsigned short*)(ws + WS_Y), (const float*)(ws + WS_SLOTW)};
        const int nwg = S.nM * S.nN, L0 = (nwg / F.G) * F.G, R = nwg - L0, SP = split_of(R, F.G < PART_CAP ? F.G : PART_CAP);
        S.Lend = L0;
        gemm_phase<EpiMoe2, MoeOrder, true>(F.lds, (const char*)(ws + WS_HM), (const char*)(ws + WS_WED), EDIM, EDIM * 2, EDIM * 2, S, E);
        if (R > 0) { MoeSplit S2{S, L0, R, SP, (EDIM / SP) * 2}; EpiPartial E2{(f32x4*)(ws + WS_PART)};
            gemm_phase<EpiPartial, MoeSplit, true>(F.lds, (const char*)(ws + WS_HM), (const char*)(ws + WS_WED), EDIM / SP, EDIM * 2, EDIM * 2, S2, E2); }
    } SEAM(12); TS_END(12);
    TS_BEGIN(13);
    if (IN(13)) { MoeOrder S; S.init((const int*)(F.ctl + CW_CNT), D / BM, F.G, bx, D); S.rev = 1; const int nwg = S.nM * S.nN, L0 = (nwg / F.G) * F.G, R = nwg - L0;
        if (R > 0) p12c_combine(F, S, L0, R, split_of(R, F.G < PART_CAP ? F.G : PART_CAP)); } SEAM(13); TS_END(13);
    TS_BEGIN(14);
    if (IN(14)) {
#if PROBE_REP == 9
        F.dry = 1; p12_final(F, args); F.dry = 0;
#endif
        p12_final(F, args); } TS_END(14);
    if (PROBE_TS != 0 && blockIdx.x == 0) { const unsigned long long te = __builtin_amdgcn_s_memrealtime(); while (__builtin_amdgcn_s_memrealtime() - te < ts_acc) __builtin_amdgcn_s_sleep(8); }
#undef IN
#undef SEAM
}
}
extern "C" void kernel_launch(void* const* d_in, const int* in_sizes, int n_in, void* d_out, int out_size, void* d_ws, size_t ws_size, hipStream_t stream) {
    static int grid = 0;
    if (grid == 0) {
        if (n_in != 20 || out_size != mk::T * mk::D || ws_size < mk::WS_END) { fprintf(stderr, "kernel_launch: unexpected sizes (ws %zu)\n", ws_size); grid = -1; return; }
        int dev = 0, cus = 0;
        if (hipGetDevice(&dev) != hipSuccess || hipDeviceGetAttribute(&cus, hipDeviceAttributeMultiprocessorCount, dev) != hipSuccess) { grid = -1; return; }
        if (hipFuncSetAttribute((const void*)mk::fwd, hipFuncAttributeMaxDynamicSharedMemorySize, mk::LDS_BYTES) != hipSuccess) { fprintf(stderr, "kernel_launch: hipFuncSetAttribute failed\n"); grid = -1; return; }
        if (cus < 256) { fprintf(stderr, "kernel_launch: built for a 256-CU device (every workgroup must be resident: one per CU); this device has %d CUs; nothing launched\n", cus); grid = -1; return; }
        grid = 256;
    }
    if (grid < 0) return;
    unsigned char* ws = (unsigned char*)d_ws;
    (void)hipMemsetAsync(ws + mk::WS_CTL, 0, mk::CTL_ZERO_BYTES, stream);
    mk::Args a; for (int i = 0; i < 20; ++i) a.in[i] = (const float*)d_in[i];
    a.out = (float*)d_out; a.ws = ws; a.flags = mk::FL_L0 | mk::FL_EXPERTS | (PROBE_REP << 8) | (PROBE_DRY << 16); a.pad = 0;
    a.ph_lo = 0; a.ph_hi = mk::NPH; hipLaunchKernelGGL(mk::fwd, dim3(grid), dim3(512), mk::LDS_BYTES, stream, a);
}
```
